# Optimizing an MI355X kernel written in HIP

```python
import jax, jax.numpy as jnp
from jax import lax
import numpy as np

D_MODEL = 2048
BATCH = 4
SEQ = 2048
DEPTH = 1
DEC_BATCH = 128
DEC_SEQ = 1
PAST_LEN = 16384
PAGE_SIZE = 128

MIX_WIDTH = D_MODEL
W_LRU = MIX_WIDTH // 2
LRU_HEADS = 8
LRU_HD = W_LRU // LRU_HEADS
CONV_W = 4
LRU_C = 8.0
W_POOL = MIX_WIDTH - W_LRU
POOL_WINDOWS = (2, 4, 8, 16)
POOL_GROUPS = len(POOL_WINDOWS)
POOL_GD = W_POOL // POOL_GROUPS
POOL_BUF = max(POOL_WINDOWS) - 1
D_FF = 4 * D_MODEL
EPS = 1e-6

kernel_name = "hymba_rglru_pool_decode_step"


def rmsnorm(x, g):
    xf = x.astype(jnp.float32)
    y = xf * lax.rsqrt(jnp.mean(xf * xf, axis=-1, keepdims=True) + EPS)
    return (y * g.astype(jnp.float32)).astype(x.dtype)


def causal_conv(u, buf, w, b):
    T = u.shape[1]
    ext = jnp.concatenate([buf.astype(jnp.float32), u.astype(jnp.float32)], axis=1)
    out = b.astype(jnp.float32)
    for k in range(CONV_W):
        out = out + ext[:, k:k + T] * w[k].astype(jnp.float32)
    return out, ext[:, -(CONV_W - 1):].astype(u.dtype)


def rg_lru(x, h0, pos, w_a, b_a, w_x, b_x, lam):
    B, T, _ = x.shape
    xh = x.reshape(B, T, LRU_HEADS, LRU_HD)
    r = jax.nn.sigmoid(jnp.einsum('bthi,hij->bthj', xh, w_a.astype(jnp.float32)).reshape(B, T, W_LRU) + b_a.astype(jnp.float32))
    i = jax.nn.sigmoid(jnp.einsum('bthi,hij->bthj', xh, w_x.astype(jnp.float32)).reshape(B, T, W_LRU) + b_x.astype(jnp.float32))
    log_a = -LRU_C * r * jax.nn.softplus(-lam.astype(jnp.float32))
    a = jnp.exp(log_a)
    mult = jnp.sqrt(1.0 - jnp.exp(2.0 * log_a))
    mult = jnp.where((pos == 0)[None, :, None], 1.0, mult)
    bx = x * i * mult

    def combine(l, rr):
        a1, b1 = l
        a2, b2 = rr
        return a1 * a2, a2 * b1 + b2

    a_cum, b_cum = lax.associative_scan(combine, (a, bx), axis=1)
    h = a_cum * h0.astype(jnp.float32)[:, None, :] + b_cum
    return h, h[:, -1]


def pool_mix(u, buf, pos, w_pool, scale):
    B, T, _ = u.shape
    ext = jnp.concatenate([buf.astype(jnp.float32), u.astype(jnp.float32)], axis=1)
    cs0 = jnp.concatenate([jnp.zeros((B, 1, W_POOL), jnp.float32), jnp.cumsum(ext, axis=1)], axis=1)
    start = POOL_BUF + 1
    cur = ext[:, POOL_BUF:]
    outs = []
    for g, w in enumerate(POOL_WINDOWS):
        sl = slice(g * POOL_GD, (g + 1) * POOL_GD)
        wsum = cs0[:, start:start + T, sl] - cs0[:, start - w:start - w + T, sl]
        count = jnp.minimum(pos + 1, w).astype(jnp.float32)[None, :, None]
        outs.append(wsum / count - cur[:, :, sl])
    pooled = jnp.stack(outs, axis=2)
    y = jnp.einsum('btgi,gij->btgj', pooled, w_pool.astype(jnp.float32)).reshape(B, T, W_POOL)
    y = y * scale.astype(jnp.float32)
    return y, ext[:, -POOL_BUF:].astype(u.dtype)


def layer(x, lru_h0, conv_buf, pool_buf, pos, norm_mix_g, w_in, conv_w, conv_b, w_rg_a, b_rg_a,
          w_rg_x, b_rg_x, lru_lambda, w_pool, pool_scale, w_out, norm_mlp_g, w_up, w_down):
    h = rmsnorm(x, norm_mix_g)
    proj = jnp.einsum('btd,de->bte', h, w_in)
    u_x = proj[..., :W_LRU]
    u_gate = proj[..., W_LRU:2 * W_LRU]
    u_pool = proj[..., 2 * W_LRU:]
    xc, new_conv = causal_conv(u_x, conv_buf, conv_w, conv_b)
    hs, h_last = rg_lru(xc, lru_h0, pos, w_rg_a, b_rg_a, w_rg_x, b_rg_x, lru_lambda)
    y_lru = hs * jax.nn.gelu(u_gate.astype(jnp.float32), approximate=True)
    y_pool, new_pool = pool_mix(u_pool, pool_buf, pos, w_pool, pool_scale)
    y_mix = jnp.concatenate([y_lru, y_pool], axis=-1).astype(x.dtype)
    x = x + jnp.einsum('bte,ed->btd', y_mix, w_out)
    h2 = rmsnorm(x, norm_mlp_g)
    f = jax.nn.relu(jnp.einsum('btd,df->btf', h2, w_up))
    x = x + jnp.einsum('btf,fd->btd', f * f, w_down)
    return x, h_last.astype(x.dtype), new_conv, new_pool


def setup_inputs(seed: int = 0) -> dict:
    key = jax.random.key(seed)
    ks = jax.random.split(key, 24)
    f32 = jnp.float32
    nrm = lambda k, s, sc: jax.random.normal(k, s, f32) * sc
    a0 = jax.random.uniform(ks[10], (DEPTH, W_LRU), f32, 0.9, 0.999)
    base = a0 ** (1.0 / LRU_C)
    lru_lambda = jnp.log(base) - jnp.log1p(-base)
    return {
        "x_prompt": nrm(ks[0], (BATCH, SEQ, D_MODEL), 1.0),
        "x_sample": nrm(ks[1], (DEC_BATCH, DEC_SEQ, D_MODEL), 1.0),
        "state_lru_h": nrm(ks[2], (DEPTH, DEC_BATCH, W_LRU), 0.5),
        "state_conv": nrm(ks[3], (DEPTH, DEC_BATCH, CONV_W - 1, W_LRU), 1.0),
        "state_pool": nrm(ks[4], (DEPTH, DEC_BATCH, POOL_BUF, W_POOL), 1.0),
        "norm_mix_g": 1.0 + nrm(ks[5], (DEPTH, D_MODEL), 0.02),
        "w_in": nrm(ks[6], (DEPTH, D_MODEL, 2 * W_LRU + W_POOL), D_MODEL ** -0.5),
        "conv_w": nrm(ks[7], (DEPTH, CONV_W, W_LRU), CONV_W ** -0.5),
        "conv_b": nrm(ks[8], (DEPTH, W_LRU), 0.01),
        "w_rg_a": nrm(ks[9], (DEPTH, LRU_HEADS, LRU_HD, LRU_HD), LRU_HD ** -0.5),
        "b_rg_a": nrm(ks[11], (DEPTH, W_LRU), 0.01),
        "w_rg_x": nrm(ks[12], (DEPTH, LRU_HEADS, LRU_HD, LRU_HD), LRU_HD ** -0.5),
        "b_rg_x": nrm(ks[13], (DEPTH, W_LRU), 0.01),
        "lru_lambda": lru_lambda,
        "w_pool": nrm(ks[14], (DEPTH, POOL_GROUPS, POOL_GD, POOL_GD), POOL_GD ** -0.5),
        "pool_scale": 0.5 + nrm(ks[15], (DEPTH, W_POOL), 0.05),
        "w_out": nrm(ks[16], (DEPTH, MIX_WIDTH, D_MODEL), MIX_WIDTH ** -0.5),
        "norm_mlp_g": 1.0 + nrm(ks[17], (DEPTH, D_MODEL), 0.02),
        "w_up": nrm(ks[18], (DEPTH, D_MODEL, D_FF), D_MODEL ** -0.5),
        "w_down": nrm(ks[19], (DEPTH, D_FF, D_MODEL), D_FF ** -0.5),
        "norm_final_g": 1.0 + nrm(ks[20], (D_MODEL,), 0.02),
    }


def reference(x_prompt, x_sample, state_lru_h, state_conv, state_pool, norm_mix_g, w_in, conv_w, conv_b,
              w_rg_a, b_rg_a, w_rg_x, b_rg_x, lru_lambda, w_pool, pool_scale, w_out, norm_mlp_g,
              w_up, w_down, norm_final_g):
    Bp, Tp, _ = x_prompt.shape
    Bs, Ts, _ = x_sample.shape
    pos_p = jnp.arange(Tp, dtype=jnp.int32)
    pos_s = PAST_LEN + jnp.arange(Ts, dtype=jnp.int32)
    xp, xs = x_prompt, x_sample
    hp_l, cp_l, pp_l, hs_l, cs_l, ps_l = [], [], [], [], [], []
    for l in range(DEPTH):
        wts = (norm_mix_g[l], w_in[l], conv_w[l], conv_b[l], w_rg_a[l], b_rg_a[l], w_rg_x[l], b_rg_x[l],
               lru_lambda[l], w_pool[l], pool_scale[l], w_out[l], norm_mlp_g[l], w_up[l], w_down[l])
        h0 = jnp.zeros((Bp, W_LRU), jnp.float32)
        cb0 = jnp.zeros((Bp, CONV_W - 1, W_LRU), xp.dtype)
        pb0 = jnp.zeros((Bp, POOL_BUF, W_POOL), xp.dtype)
        xp, hp, cp, pp = layer(xp, h0, cb0, pb0, pos_p, *wts)
        xs, hs, cs, ps = layer(xs, state_lru_h[l], state_conv[l], state_pool[l], pos_s, *wts)
        hp_l.append(hp); cp_l.append(cp); pp_l.append(pp)
        hs_l.append(hs); cs_l.append(cs); ps_l.append(ps)
    y_prompt = rmsnorm(xp, norm_final_g)
    y_sample = rmsnorm(xs, norm_final_g)
    return (y_prompt, y_sample, jnp.stack(hp_l), jnp.stack(cp_l), jnp.stack(pp_l),
            jnp.stack(hs_l), jnp.stack(cs_l), jnp.stack(ps_l))
```

```cpp
#include <hip/hip_runtime.h>
#include <cstdio>
#include <cstdint>
namespace pg8 {
#define PG8_LAS __attribute__((address_space(3)))
typedef unsigned short bf16_t;
typedef short bf16x8 __attribute__((ext_vector_type(8)));
typedef float f32x4 __attribute__((ext_vector_type(4)));
typedef unsigned u32x4 __attribute__((ext_vector_type(4)));
constexpr int BM = 256, BK = 64, HALF = 128, HTB = HALF * BK * 2  , STAGE_BYTES = 8 * HTB, NXCD = 8, WGM = 8;

__host__ __device__ __forceinline__ int lds_byte(int r, int c) { const int st = (r >> 4) * 2 + (c >> 5), rr = r & 15, cc = c & 31, ob = rr * 64 + cc * 2; return st * 1024 + (ob ^ (((ob >> 9) & 1) << 5)); }
__host__ __device__ __forceinline__ void stage_rc(int b, int& R, int& C) { const int st = b / 1024, sb = b % 1024, swz = sb ^ (((sb >> 9) & 1) << 5); R = (st >> 1) * 16 + swz / 64; C = (st & 1) * 32 + (swz % 64) / 2; }
__host__ __device__ __forceinline__ int perm32(int rho) { const int n = rho >> 4, i = rho & 15; return 8 * (i >> 2) + 4 * n + (i & 3); }

struct Unit { int pm, pn; };
struct Gemm { const bf16_t* A; const bf16_t* Bt; int M, N, K; };

struct StaticOrder {
    int nM, nN, nwg, G, c;
    __host__ __device__ void init(int M, int N, int G_, int c_) { nM = M / BM; nN = N / BM; nwg = nM * nN; G = G_; c = c_; }
    __host__ __device__ bool next(int i, Unit& u) const {
        const long L = (long)i * G + c; if (L >= nwg) return false;
        int wgid = (int)L; { const int q = nwg / NXCD, r = nwg % NXCD, xcd = wgid % NXCD, off = wgid / NXCD; wgid = (xcd < r ? xcd * (q + 1) : r * (q + 1) + (xcd - r) * q) + off; }
        const int nig = WGM * nN, gid = wgid / nig, fm = gid * WGM, gsz = (nM - fm) < WGM ? (nM - fm) : WGM;
        u.pm = fm + ((wgid % nig) % gsz); u.pn = (wgid % nig) / gsz; return true;
    }
    __device__ __forceinline__ void a_ready(const Unit&) const {}
    __device__ __forceinline__ void done(const Unit&) const {}
};

__device__ __forceinline__ unsigned cvt_pk_bf16(float lo, float hi) { unsigned r; asm volatile("v_cvt_pk_bf16_f32 %0, %1, %2" : "=v"(r) : "v"(lo), "v"(hi)); return r; }
typedef float f32x2 __attribute__((ext_vector_type(2)));
constexpr int E_D = 2048, E_TP = 8192, E_M = 8320, E_FF = 8192;
constexpr float E_EPS = 1e-6f;
__device__ __forceinline__ float dot4(const f32x4 v) { return (v[0] * v[0] + v[1] * v[1]) + (v[2] * v[2] + v[3] * v[3]); }

struct EpiU {
    static constexpr bool PERM = false, AFTER_DRAIN = false;
    float* C; int ldc;
    __device__ __forceinline__ void operator()(const f32x4 (&acc)[2][2][4][2], const Unit& u, int wr, int wc, int fr, int fq) const {
        const int row0 = u.pm * BM + wr * 64 + fr, col0 = u.pn * BM + wc * 32 + 4 * fq;
#pragma unroll
        for (int ai = 0; ai < 2; ++ai)
#pragma unroll
            for (int m = 0; m < 4; ++m) { const int row = row0 + ai * HALF + m * 16;
                if (row < E_M) { float* rowp = C + (size_t)row * ldc + col0;
#pragma unroll
                    for (int bj = 0; bj < 2; ++bj)
#pragma unroll
                        for (int n = 0; n < 2; ++n) *(f32x4*)(rowp + bj * HALF + n * 16) = acc[ai][bj][m][n]; } }
    }
};
struct EpiOut {
    static constexpr bool PERM = true, AFTER_DRAIN = false;
    const float* xp; const float* xs; float* X1; bf16_t* X1b; float* rowsq;
    __device__ __forceinline__ void operator()(const f32x4 (&acc)[2][2][4][2], const Unit& u, int wr, int wc, int fr, int fq) const {
        const int row0 = u.pm * BM + wr * 64 + fr, col0 = u.pn * BM + wc * 32 + 8 * fq;
#pragma unroll
        for (int ai = 0; ai < 2; ++ai)
#pragma unroll
            for (int m = 0; m < 4; ++m) { const int row = row0 + ai * HALF + m * 16;
                if (row < E_M) {
                    const float* xr = (row < E_TP ? xp + (size_t)row * E_D : xs + (size_t)(row - E_TP) * E_D) + col0;
                    float* o1 = X1 + (size_t)row * E_D + col0; bf16_t* ob = X1b + (size_t)row * E_D + col0; float ss = 0.f;
#pragma unroll
                    for (int bj = 0; bj < 2; ++bj) {
                        const f32x4 v0 = acc[ai][bj][m][0] + *(const f32x4*)(xr + bj * HALF), v1 = acc[ai][bj][m][1] + *(const f32x4*)(xr + bj * HALF + 4);
                        *(f32x4*)(o1 + bj * HALF) = v0; *(f32x4*)(o1 + bj * HALF + 4) = v1; ss += dot4(v0) + dot4(v1);
                        u32x4 w; w.x = cvt_pk_bf16(v0[0], v0[1]); w.y = cvt_pk_bf16(v0[2], v0[3]); w.z = cvt_pk_bf16(v1[0], v1[1]); w.w = cvt_pk_bf16(v1[2], v1[3]);
                        *(u32x4*)(ob + bj * HALF) = w; }
                    ss += __shfl_xor(ss, 16); ss += __shfl_xor(ss, 32);
                    if (fq == 0) rowsq[(size_t)row * 32 + u.pn * 4 + wc] = ss; } }
    }
};
struct EpiUp {
    static constexpr bool PERM = true, AFTER_DRAIN = false;
    bf16_t* F; const float* rowsq;
    __device__ __forceinline__ void operator()(const f32x4 (&acc)[2][2][4][2], const Unit& u, int wr, int wc, int fr, int fq) const {
        const int row0 = u.pm * BM + wr * 64 + fr, col0 = u.pn * BM + wc * 32 + 8 * fq;
#pragma unroll
        for (int ai = 0; ai < 2; ++ai)
#pragma unroll
            for (int m = 0; m < 4; ++m) { const int row = row0 + ai * HALF + m * 16;
                float s = 0.f;
                if (row < E_M) { const float* rp = rowsq + (size_t)row * 32 + fq * 8; const f32x4 p0 = *(const f32x4*)rp, p1 = *(const f32x4*)(rp + 4);
                    float t = ((p0[0] + p0[1]) + (p0[2] + p0[3])) + ((p1[0] + p1[1]) + (p1[2] + p1[3])); t += __shfl_xor(t, 16); t += __shfl_xor(t, 32);
                    s = 1.0f / sqrtf(t * (1.0f / E_D) + E_EPS); }
                bf16_t* ob = F + (size_t)row * E_FF + col0;
#pragma unroll
                for (int bj = 0; bj < 2; ++bj) {
                    f32x4 v0 = acc[ai][bj][m][0] * s, v1 = acc[ai][bj][m][1] * s;
#pragma unroll
                    for (int j = 0; j < 4; ++j) { const float a = fmaxf(v0[j], 0.f), b = fmaxf(v1[j], 0.f); v0[j] = a * a; v1[j] = b * b; }
                    u32x4 w; w.x = cvt_pk_bf16(v0[0], v0[1]); w.y = cvt_pk_bf16(v0[2], v0[3]); w.z = cvt_pk_bf16(v1[0], v1[1]); w.w = cvt_pk_bf16(v1[2], v1[3]);
                    *(u32x4*)(ob + bj * HALF) = w; } }
    }
};
struct EpiDown {
    static constexpr bool PERM = false, AFTER_DRAIN = false;
    float* X; float* rowsq;
    __device__ __forceinline__ void operator()(const f32x4 (&acc)[2][2][4][2], const Unit& u, int wr, int wc, int fr, int fq) const {
        const int row0 = u.pm * BM + wr * 64 + fr, col0 = u.pn * BM + wc * 32 + 4 * fq;
#pragma unroll
        for (int ai = 0; ai < 2; ++ai)
#pragma unroll
            for (int m = 0; m < 4; ++m) { const int row = row0 + ai * HALF + m * 16;
                if (row < E_M) { float* rowp = X + (size_t)row * E_D + col0; float ss = 0.f;
#pragma unroll
                    for (int bj = 0; bj < 2; ++bj)
#pragma unroll
                        for (int n = 0; n < 2; ++n) { const f32x4 v = acc[ai][bj][m][n] + *(const f32x4*)(rowp + bj * HALF + n * 16); *(f32x4*)(rowp + bj * HALF + n * 16) = v; ss += dot4(v); }
                    ss += __shfl_xor(ss, 16); ss += __shfl_xor(ss, 32);
                    if (fq == 0) rowsq[(size_t)row * 32 + u.pn * 4 + wc] = ss; } }
    }
};

template <class Epi, class Sched, bool ALIGN_EPI = false, bool SP2 = false>
__device__ __forceinline__ void gemm_phase(PG8_LAS unsigned char* lds, const Gemm g, const Sched& S, const Epi& E) {
    const int tid = threadIdx.x, wid = __builtin_amdgcn_readfirstlane(tid >> 6), lane = tid & 63, wr = wid >> 2, wc = wid & 3, fr = lane & 15, fq = lane >> 4;
    const int K = g.K, nt = K / BK;
    unsigned voffA[2], voffB[2];
#pragma unroll
    for (int i = 0; i < 2; ++i) { int R, C; stage_rc(tid * 16 + i * 8192, R, C); const int Rb = Epi::PERM ? ((R & ~31) + perm32(R & 31)) : R;
        voffA[i] = (unsigned)(R * K + C) * 2u; voffB[i] = (unsigned)(Rb * K + C) * 2u; }
    const size_t kstep = (size_t)(BK * 2);
    const size_t hstep = (size_t)HALF * K * 2;
    const size_t tstep = 2 * hstep;
    const unsigned ldsw = (unsigned)wid * 1024u;
    const int aoff = lds_byte(wr * 64 + fr, fq * 8), boff = lds_byte(wc * 32 + fr, fq * 8);
#define PG8_SA(b, h) (((b) * 2 + (h)) * HTB)
#define PG8_SB(b, h) ((4 + (b) * 2 + (h)) * HTB)
#define PG8_STAGE(bufoff, gbase, voff) do { _Pragma("unroll") for (int _i = 0; _i < 2; ++_i) \
        __builtin_amdgcn_global_load_lds((const unsigned*)((const char*)(gbase) + (voff)[_i]), (PG8_LAS unsigned*)(lds + (bufoff) + ldsw + _i * 8192), 16, 0, 0); } while (0)
#define PG8_LDA(dst, b, h) do { _Pragma("unroll") for (int m = 0; m < 4; ++m) _Pragma("unroll") for (int k = 0; k < 2; ++k) dst[m][k] = *(const PG8_LAS bf16x8*)(lds + PG8_SA(b, h) + aoff + m * 2048 + k * 1024); } while (0)
#define PG8_LDB(dst, b, h) do { _Pragma("unroll") for (int n = 0; n < 2; ++n) _Pragma("unroll") for (int k = 0; k < 2; ++k) dst[n][k] = *(const PG8_LAS bf16x8*)(lds + PG8_SB(b, h) + boff + n * 2048 + k * 1024); } while (0)
#define PG8_MMA(ai, bj, At, Bt) do { __builtin_amdgcn_s_setprio(1); _Pragma("unroll") for (int m = 0; m < 4; ++m) _Pragma("unroll") for (int n = 0; n < 2; ++n) _Pragma("unroll") for (int k = 0; k < 2; ++k) \
        acc[ai][bj][m][n] = __builtin_amdgcn_mfma_f32_16x16x32_bf16(Bt[n][k], At[m][k], acc[ai][bj][m][n], 0, 0, 0); __builtin_amdgcn_s_setprio(0); } while (0)
#define PG8_WAIT_V(n) asm volatile("s_waitcnt vmcnt(" #n ")" ::: "memory")
#define PG8_WAIT_L(n) asm volatile("s_waitcnt lgkmcnt(" #n ")" ::: "memory")
#define PG8_BAR __builtin_amdgcn_s_barrier()
#define PG8_SCHED __builtin_amdgcn_sched_barrier(0)
    Unit cur, nxt; int ui = 0;
    if (!S.next(0, cur)) return;
    f32x4 acc[2][2][4][2];
#pragma unroll
    for (int a = 0; a < 2; ++a)
#pragma unroll
        for (int b = 0; b < 2; ++b)
#pragma unroll
            for (int m = 0; m < 4; ++m)
#pragma unroll
                for (int n = 0; n < 2; ++n) acc[a][b][m][n] = (f32x4){0.f, 0.f, 0.f, 0.f};
    bf16x8 At[4][2], B0[2][2], B1[2][2];
    const char* cA = (const char*)g.A + (size_t)cur.pm * tstep; const char* cB = (const char*)g.Bt + (size_t)cur.pn * tstep;
    S.a_ready(cur);
    if constexpr (SP2) {
        PG8_STAGE(PG8_SB(0, 0), cB, voffB); PG8_STAGE(PG8_SB(0, 1), cB + hstep, voffB); PG8_STAGE(PG8_SA(0, 0), cA, voffA); PG8_STAGE(PG8_SA(0, 1), cA + hstep, voffA);
        if (wr == 1) PG8_BAR;
        PG8_WAIT_V(2); PG8_BAR;
        PG8_STAGE(PG8_SB(1, 0), cB + kstep, voffB); PG8_STAGE(PG8_SA(1, 0), cA + kstep, voffA); PG8_STAGE(PG8_SB(1, 1), cB + hstep + kstep, voffB);
        PG8_WAIT_V(6); PG8_BAR;
    } else {
        PG8_STAGE(PG8_SB(0, 0), cB, voffB); PG8_STAGE(PG8_SA(0, 0), cA, voffA); PG8_STAGE(PG8_SB(0, 1), cB + hstep, voffB); PG8_STAGE(PG8_SA(0, 1), cA + hstep, voffA);
        if (wr == 1) PG8_BAR;
        PG8_WAIT_V(4); PG8_BAR;
        PG8_STAGE(PG8_SB(1, 0), cB + kstep, voffB); PG8_STAGE(PG8_SA(1, 0), cA + kstep, voffA); PG8_STAGE(PG8_SB(1, 1), cB + hstep + kstep, voffB);
        PG8_WAIT_V(6); PG8_BAR;
    }
    for (;;) {
        const bool has_next = S.next(ui + 1, nxt);
        const char* nA = has_next ? (const char*)g.A + (size_t)nxt.pm * tstep : cA; const char* nB = has_next ? (const char*)g.Bt + (size_t)nxt.pn * tstep : cB;
        for (int t = 0; t < nt; t += 2) {
            const bool last = (t == nt - 2);
            const char* a1 = cA + (size_t)(t + 1) * kstep;
            const char* a2 = last ? nA : cA + (size_t)(t + 2) * kstep; const char* b2 = last ? nB : cB + (size_t)(t + 2) * kstep;
            const char* a3 = a2 + kstep; const char* b3 = b2 + kstep;
            if (last && has_next) S.a_ready(nxt);
            if constexpr (SP2) {
            PG8_LDB(B0, 0, 0); PG8_LDB(B1, 0, 1); PG8_SCHED; PG8_LDA(At, 0, 0); PG8_STAGE(PG8_SA(1, 1), a1 + hstep, voffA);
            PG8_WAIT_V(8); PG8_WAIT_L(0); PG8_BAR; PG8_MMA(0, 0, At, B0); PG8_MMA(0, 1, At, B1); PG8_BAR; PG8_SCHED;
            PG8_LDA(At, 0, 1); PG8_STAGE(PG8_SB(0, 0), b2, voffB); PG8_STAGE(PG8_SB(0, 1), b2 + hstep, voffB); PG8_STAGE(PG8_SA(0, 0), a2, voffA);
            PG8_WAIT_V(8); PG8_WAIT_L(0); PG8_BAR; PG8_MMA(1, 0, At, B0); PG8_MMA(1, 1, At, B1); PG8_BAR; PG8_SCHED;
            PG8_LDB(B0, 1, 0); PG8_LDB(B1, 1, 1); PG8_SCHED; PG8_LDA(At, 1, 0); PG8_STAGE(PG8_SA(0, 1), a2 + hstep, voffA);
            PG8_WAIT_V(8); PG8_WAIT_L(0); PG8_BAR; PG8_MMA(0, 0, At, B0); PG8_MMA(0, 1, At, B1); PG8_BAR; PG8_SCHED;
            PG8_LDA(At, 1, 1); PG8_STAGE(PG8_SB(1, 0), b3, voffB); PG8_STAGE(PG8_SB(1, 1), b3 + hstep, voffB); PG8_STAGE(PG8_SA(1, 0), a3, voffA);
            PG8_WAIT_V(8); PG8_WAIT_L(0); PG8_BAR; PG8_MMA(1, 0, At, B0); PG8_MMA(1, 1, At, B1); PG8_BAR; PG8_SCHED;
            } else {
            PG8_LDB(B0, 0, 0); PG8_SCHED; PG8_LDA(At, 0, 0); PG8_STAGE(PG8_SA(1, 1), a1 + hstep, voffA);
            PG8_WAIT_L(8); PG8_BAR; PG8_WAIT_L(0); PG8_MMA(0, 0, At, B0); PG8_BAR; PG8_SCHED;
            PG8_LDB(B1, 0, 1); PG8_STAGE(PG8_SB(0, 0), b2, voffB);
            PG8_BAR; PG8_WAIT_L(0); PG8_MMA(0, 1, At, B1); PG8_BAR;
            PG8_LDA(At, 0, 1); PG8_STAGE(PG8_SA(0, 0), a2, voffA);
            PG8_BAR; PG8_WAIT_L(0); PG8_MMA(1, 0, At, B0); PG8_BAR; PG8_SCHED;
            PG8_STAGE(PG8_SB(0, 1), b2 + hstep, voffB);
            PG8_WAIT_V(6); PG8_BAR; PG8_MMA(1, 1, At, B1); PG8_BAR;
            PG8_LDB(B0, 1, 0); PG8_SCHED; PG8_LDA(At, 1, 0); PG8_STAGE(PG8_SA(0, 1), a2 + hstep, voffA);
            PG8_WAIT_L(8); PG8_BAR; PG8_WAIT_L(0); PG8_MMA(0, 0, At, B0); PG8_BAR; PG8_SCHED;
            PG8_LDB(B1, 1, 1); PG8_STAGE(PG8_SB(1, 0), b3, voffB);
            PG8_BAR; PG8_WAIT_L(0); PG8_MMA(0, 1, At, B1); PG8_BAR;
            PG8_LDA(At, 1, 1); PG8_STAGE(PG8_SA(1, 0), a3, voffA);
            PG8_BAR; PG8_WAIT_L(0); PG8_MMA(1, 0, At, B0); PG8_BAR; PG8_SCHED;
            PG8_STAGE(PG8_SB(1, 1), b3 + hstep, voffB);
            PG8_WAIT_V(6); PG8_BAR; PG8_MMA(1, 1, At, B1); PG8_BAR;
            }
        }
        if constexpr (ALIGN_EPI) { if (wr == 0) PG8_BAR; }
        if constexpr (!Epi::AFTER_DRAIN) { E(acc, cur, wr, wc, fr, fq); S.done(cur); }
        if (!has_next) break;
#pragma unroll
        for (int a = 0; a < 2; ++a)
#pragma unroll
            for (int b = 0; b < 2; ++b)
#pragma unroll
                for (int m = 0; m < 4; ++m)
#pragma unroll
                    for (int n = 0; n < 2; ++n) acc[a][b][m][n] = (f32x4){0.f, 0.f, 0.f, 0.f};
        cur = nxt; cA = nA; cB = nB; ++ui;
        if constexpr (ALIGN_EPI) { if (wr == 1) PG8_BAR; }
    }
    PG8_WAIT_V(0);
    if constexpr (!ALIGN_EPI) { if (wr == 0) PG8_BAR; }
    PG8_BAR;
    if constexpr (Epi::AFTER_DRAIN) { E.fused(acc, cur, wr, wc, fr, fq, lds, wid, lane); S.done(cur); }
#undef PG8_SA
#undef PG8_SB
#undef PG8_STAGE
#undef PG8_LDA
#undef PG8_LDB
#undef PG8_MMA
#undef PG8_WAIT_V
#undef PG8_WAIT_L
#undef PG8_BAR
#undef PG8_SCHED
}
}
#ifndef MK_N_LAUNCHES
#define MK_N_LAUNCHES 1
#endif
constexpr int NWAVES = 8, NPHASE = 8;
constexpr int D = 2048, TP = 8192, TS = 128, MTOT = 8320, MP = 8448, SEQ = 2048, NB = 4, NIN = 3072, WL = 1024, FF = 8192;
constexpr float EPS = 1e-6f;
constexpr size_t MiB = 1u << 20;
constexpr size_t WS_CTL = 0, CTL_ZERO_BYTES = 1 * MiB;
constexpr size_t WS_WUP = 1 * MiB, WS_WDOWN = 33 * MiB, WS_WIN = 65 * MiB, WS_WOUT = 77 * MiB, WS_WA = 85 * MiB, WS_WX = WS_WA + 256 * 1024, WS_WPOOL = WS_WA + 512 * 1024;
constexpr size_t WS_H = 86 * MiB;
constexpr size_t WS_U = 119 * MiB;
constexpr size_t WS_X1B = 197 * MiB;
constexpr size_t WS_F = 65 * MiB;
constexpr size_t WS_AGGA = 231 * MiB, WS_AGGB = 232 * MiB;
constexpr size_t WS_END = 256 * MiB;
static_assert(WS_F + (size_t)MP * FF * 2 <= WS_X1B && WS_X1B + (size_t)MP * D * 2 <= WS_AGGA && WS_U + (size_t)MTOT * NIN * 4 <= WS_AGGA, "d_ws map");
constexpr int CW_BAR = 4096;
constexpr size_t WS_RSQ1 = 233 * MiB, WS_RSQ2 = 235 * MiB;
constexpr size_t O_Y = 0, O_HP = 17039360, O_CP = 17043456, O_PP = 17055744, O_HS = 17117184, O_CS = 17248256, O_PS = 17641472, O_END = 19607552;
constexpr size_t O_ACUM = 0, O_BCUM = 8388608;
constexpr int RING_BYTES = 131072, LDSCTL_OFF = RING_BYTES, LDS_BYTES = 147456;

#define LAS __attribute__((address_space(3)))
typedef unsigned short bf16;
typedef unsigned v4u __attribute__((ext_vector_type(4)));
typedef unsigned v2u __attribute__((ext_vector_type(2)));
typedef float f32x4 __attribute__((ext_vector_type(4)));
typedef float f32x2 __attribute__((ext_vector_type(2)));
typedef short bf16x8 __attribute__((ext_vector_type(8)));
#define LDS_WAIT() asm volatile("s_waitcnt lgkmcnt(0)" ::: "memory")
__device__ __forceinline__ unsigned pk2(float lo, float hi) { return pg8::cvt_pk_bf16(lo, hi); }
__device__ __forceinline__ bf16 f2bf(float f) { return (bf16)(pg8::cvt_pk_bf16(f, 0.f) & 0xffffu); }
__device__ __forceinline__ float sigmoidf_(float x) { return 1.0f / (1.0f + __expf(-x)); }
__device__ __forceinline__ float gelu_tanh(float x) { const float z = 0.7978845608028654f * (x + 0.044715f * x * x * x); const float t = 1.0f - 2.0f / (1.0f + __expf(2.0f * z)); return 0.5f * x * (1.0f + t); }

#define XB_TMO      128
#define XB_XCNT(j)  (256  + 64 * (j))
#define XB_XSUB(j)  (1280 + 64 * (j))
#define XB_XGEN(j)  (2304 + 64 * (j))
#define XB_TOP      3328
#define XB_TOPGEN   3392
#define XCD_BAR_WORDS 3456
#define XB_SPIN_CAP (1u << 18)

__device__ __forceinline__ unsigned xb_ld(unsigned* p)              { return __hip_atomic_load(p, __ATOMIC_RELAXED, __HIP_MEMORY_SCOPE_AGENT); }
__device__ __forceinline__ unsigned xb_add(unsigned* p, unsigned v) { return __hip_atomic_fetch_add(p, v, __ATOMIC_RELAXED, __HIP_MEMORY_SCOPE_AGENT); }
__device__ __forceinline__ unsigned xb_xcc_id() { return (unsigned)__builtin_amdgcn_s_getreg((3 << 11) | 20) & 0xFu; }
#define XB_SPIN(cond, bar) do { unsigned _sp = 0; while (cond) { __builtin_amdgcn_s_sleep(1); \
    if ((++_sp & 255u) == 0u) { if (xb_ld(&(bar)[XB_TMO])) break; if (_sp > XB_SPIN_CAP) { atomicAdd(&(bar)[XB_TMO], 1u); break; } } } } while (0)

struct XcdBarrier {
    unsigned* bar; unsigned x;
    volatile LAS unsigned* st;
};

__device__ __forceinline__ XcdBarrier xcd_barrier_post(unsigned* bar, volatile LAS unsigned* st) {
    XcdBarrier b; b.bar = bar; b.x = xb_xcc_id(); b.st = st;
    if (threadIdx.x == 0) (void)xb_add(&bar[XB_XCNT(b.x)], 1u);
    return b;
}
__device__ __forceinline__ void xcd_barrier_complete(unsigned* bar, unsigned x, unsigned& nloc, unsigned& nx) {
    const unsigned G = gridDim.x * gridDim.y * gridDim.z;
    unsigned sum, cnt, mine, sp = 0u;
    for (;;) {
        sum = 0u; cnt = 0u; mine = 0u;
#pragma unroll
        for (unsigned j = 0; j < 16; ++j) { const unsigned c = xb_ld(&bar[XB_XCNT(j)]); sum += c; cnt += (c > 0u) ? 1u : 0u; mine = (j == x) ? c : mine; }
        if (sum == G) break;
        __builtin_amdgcn_s_sleep(1);
        if ((++sp & 255u) == 0u) { if (xb_ld(&bar[XB_TMO])) break; if (sp > XB_SPIN_CAP) { atomicAdd(&bar[XB_TMO], 1u); break; } }
    }
    nloc = mine > 0u ? mine : 1u; nx = cnt > 0u ? cnt : 1u;
}

__device__ __forceinline__ void xcd_barrier(const XcdBarrier& b) {
    asm volatile("s_waitcnt vmcnt(0)" ::: "memory");
    __syncthreads();
    if (threadIdx.x == 0) {
        unsigned* bar = b.bar;
        __builtin_amdgcn_s_waitcnt(0);
        unsigned nloc = b.st[0], nx = b.st[1];
        if (nloc == 0u) { xcd_barrier_complete(bar, b.x, nloc, nx); b.st[0] = nloc; b.st[1] = nx; }
        const unsigned old = xb_add(&bar[XB_XSUB(b.x)], 1u);
        const unsigned gen = old / nloc;
        if (old + 1u == (gen + 1u) * nloc) {
            __builtin_amdgcn_fence(__ATOMIC_RELEASE, "agent");
            asm volatile("s_waitcnt vmcnt(0)" ::: "memory");
            const unsigned og = xb_add(&bar[XB_TOP], 1u);
            const unsigned tg = og / nx;
            if (og + 1u == (tg + 1u) * nx) xb_add(&bar[XB_TOPGEN], 1u);
            else XB_SPIN(xb_ld(&bar[XB_TOPGEN]) == tg, bar);
            __builtin_amdgcn_fence(__ATOMIC_ACQUIRE, "agent");
            xb_add(&bar[XB_XGEN(b.x)], 1u);
            asm volatile("s_waitcnt vmcnt(0)" ::: "memory");
        } else {
            XB_SPIN(xb_ld(&bar[XB_XGEN(b.x)]) == gen, bar);
            __builtin_amdgcn_fence(__ATOMIC_ACQUIRE, "agent");
            asm volatile("s_waitcnt vmcnt(0)" ::: "memory");
        }
    }
    __syncthreads();
}
struct Args { const float* in[21]; float* out; unsigned char* ws; int ph_lo, ph_hi; };
enum { I_XP = 0, I_XS, I_SLRU, I_SCONV, I_SPOOL, I_GMIX, I_WIN, I_CONVW, I_CONVB, I_WA, I_BA, I_WX, I_BX, I_LAM, I_WPOOL, I_PSCALE, I_WOUT, I_GMLP, I_WUP, I_WDOWN, I_GFIN };

__device__ __forceinline__ float wave_sum(float v) {
#pragma unroll
    for (int o = 1; o < 64; o <<= 1) v += __shfl_xor(v, o);
    return v;
}
__device__ __forceinline__ void p0_transpose_item(const float* W, int K, int N, bf16* WT, const float* kscale, LAS float* scr, int item, int lane) {
    const int nblk = N / 32, kb = item / nblk, nb = item % nblk, k0 = 64 * kb, n0 = 32 * nb;
#pragma unroll 8
    for (int i = 0; i < 32; ++i) { const int kk = 2 * i + (lane >> 5); float v = W[(size_t)(k0 + kk) * N + n0 + (lane & 31)]; if (kscale) v *= kscale[k0 + kk]; scr[kk * 33 + (lane & 31)] = v; }
    LDS_WAIT(); asm volatile("" ::: "memory");
    const int c = lane & 7;
#pragma unroll
    for (int j = 0; j < 4; ++j) { const int n = (lane >> 3) + 8 * j; const LAS float* s = scr + (8 * c) * 33 + n;
        v4u o; o.x = pk2(s[0 * 33], s[1 * 33]); o.y = pk2(s[2 * 33], s[3 * 33]); o.z = pk2(s[4 * 33], s[5 * 33]); o.w = pk2(s[6 * 33], s[7 * 33]);
        *(v4u*)(WT + (size_t)(n0 + n) * K + k0 + 8 * c) = o; }
    LDS_WAIT(); asm volatile("" ::: "memory");
}

__device__ __forceinline__ void phase0(const Args& a, LAS unsigned char* lds, int G) {
    const int tid = threadIdx.x, lane = tid & 63, wave = __builtin_amdgcn_readfirstlane(tid >> 6);
    unsigned char* ws = a.ws;
    LAS float* scr = (LAS float*)(lds + wave * 16384);
    const int gw = blockIdx.x * NWAVES + wave, NGW = G * NWAVES;
    constexpr int I_IN = (D / 64) * (NIN / 32), I_OUT = (D / 64) * (D / 32), I_UP = (D / 64) * (FF / 32), I_DOWN = (FF / 64) * (D / 32), I_G = 8 * 8, I_P = 4 * 32;
    constexpr int NITEMS = I_IN + I_OUT + I_UP + I_DOWN + 2 * I_G + I_P;
    for (int m = gw; m < MP; m += NGW) {
        bf16* orow = (bf16*)(ws + WS_H) + (size_t)m * D;
        if (m >= MTOT) {
            bf16* orow2 = (bf16*)(ws + WS_X1B) + (size_t)m * D;
#pragma unroll
            for (int j = 0; j < 4; ++j) { *((v4u*)orow + lane + 64 * j) = (v4u){0u, 0u, 0u, 0u}; *((v4u*)orow2 + lane + 64 * j) = (v4u){0u, 0u, 0u, 0u}; }
            continue;
        }
        const float* xrow = (m < TP) ? a.in[I_XP] + (size_t)m * D : a.in[I_XS] + (size_t)(m - TP) * D;
        const f32x4* xr = (const f32x4*)xrow + lane; const f32x4* gr = (const f32x4*)a.in[I_GMIX] + lane;
        f32x4 v[8]; float s = 0.f;
#pragma unroll
        for (int j = 0; j < 8; ++j) { v[j] = xr[64 * j]; s += pg8::dot4(v[j]); }
        const float rstd = 1.0f / sqrtf(wave_sum(s) * (1.0f / D) + EPS);
        v2u* o8 = (v2u*)orow + lane;
#pragma unroll
        for (int j = 0; j < 8; ++j) { const f32x4 g = gr[64 * j]; v2u o; o.x = pk2(v[j][0] * rstd * g[0], v[j][1] * rstd * g[1]); o.y = pk2(v[j][2] * rstd * g[2], v[j][3] * rstd * g[3]); o8[64 * j] = o; }
    }
    for (int it = gw; it < NITEMS; it += NGW) {
        int r = it;
        if (r < I_IN) { p0_transpose_item(a.in[I_WIN], D, NIN, (bf16*)(ws + WS_WIN), nullptr, scr, r, lane); continue; } r -= I_IN;
        if (r < I_OUT) { p0_transpose_item(a.in[I_WOUT], D, D, (bf16*)(ws + WS_WOUT), nullptr, scr, r, lane); continue; } r -= I_OUT;
        if (r < I_UP) { p0_transpose_item(a.in[I_WUP], D, FF, (bf16*)(ws + WS_WUP), a.in[I_GMLP], scr, r, lane); continue; } r -= I_UP;
        if (r < I_DOWN) { p0_transpose_item(a.in[I_WDOWN], FF, D, (bf16*)(ws + WS_WDOWN), nullptr, scr, r, lane); continue; } r -= I_DOWN;
        if (r < I_G) { const int h = r >> 3; p0_transpose_item(a.in[I_WA] + h * 16384, 128, 128, (bf16*)(ws + WS_WA) + h * 16384, nullptr, scr, r & 7, lane); continue; } r -= I_G;
        if (r < I_G) { const int h = r >> 3; p0_transpose_item(a.in[I_WX] + h * 16384, 128, 128, (bf16*)(ws + WS_WX) + h * 16384, nullptr, scr, r & 7, lane); continue; } r -= I_G;
        { const int g = r >> 5; p0_transpose_item(a.in[I_WPOOL] + g * 65536, 256, 256, (bf16*)(ws + WS_WPOOL) + g * 65536, nullptr, scr, r & 31, lane); }
    }
}

constexpr int XCS = 132, XAS = 136, PAS = 264;
__device__ __forceinline__ float softplusf_(float z) { return fmaxf(z, 0.f) + log1pf(__expf(-fabsf(z))); }

__device__ __forceinline__ void lru_unit(const Args& a, LAS unsigned char* lds, bool decode, int b, int ch, int h) {
    const int tid = threadIdx.x, lane = tid & 63, wave = __builtin_amdgcn_readfirstlane(tid >> 6);
    LAS float* XC = (LAS float*)lds; LAS float* AA = (LAS float*)(lds + 33792); LAS bf16* XA = (LAS bf16*)(lds + 67584); LAS float* SG = (LAS float*)(lds + 84992);
    const float* U = (const float*)(a.ws + WS_U);
    const int c = tid & 127, tq = tid >> 7, cg = h * 128 + c, t0 = ch * 64;
    const size_t rowbase = decode ? (size_t)(TP + ch * 64) : (size_t)b * SEQ + t0;
    {
        const float* cw = a.in[I_CONVW]; const float w0 = cw[cg], w1 = cw[WL + cg], w2 = cw[2 * WL + cg], w3 = cw[3 * WL + cg], cb = a.in[I_CONVB][cg];
        const int ts = tq * 16;
        if (!decode) {
            float xm3 = (t0 + ts - 3 >= 0) ? U[(rowbase + ts - 3) * NIN + cg] : 0.f, xm2 = (t0 + ts - 2 >= 0) ? U[(rowbase + ts - 2) * NIN + cg] : 0.f, xm1 = (t0 + ts - 1 >= 0) ? U[(rowbase + ts - 1) * NIN + cg] : 0.f;
#pragma unroll 4
            for (int s = 0; s < 16; ++s) { const int t = ts + s; const float x0 = U[(rowbase + t) * NIN + cg];
                const float xc = cb + w0 * xm3 + w1 * xm2 + w2 * xm1 + w3 * x0; XC[t * XCS + c] = xc; XA[t * XAS + c] = f2bf(xc); xm3 = xm2; xm2 = xm1; xm1 = x0; }
            if (ch == SEQ / 64 - 1 && tq == 3) { float* cp = a.out + O_CP + (size_t)b * 3 * WL + cg; cp[0] = xm3; cp[WL] = xm2; cp[2 * WL] = xm1; }
        } else {
            const float* sc = a.in[I_SCONV]; float* cs = a.out + O_CS;
#pragma unroll 4
            for (int s = 0; s < 16; ++s) { const int t = ts + s; const int bi = ch * 64 + t;
                const float s0 = sc[((size_t)bi * 3 + 0) * WL + cg], s1 = sc[((size_t)bi * 3 + 1) * WL + cg], s2 = sc[((size_t)bi * 3 + 2) * WL + cg], x0 = U[(rowbase + t) * NIN + cg];
                const float xc = cb + w0 * s0 + w1 * s1 + w2 * s2 + w3 * x0; XC[t * XCS + c] = xc; XA[t * XAS + c] = f2bf(xc);
                cs[((size_t)bi * 3 + 0) * WL + cg] = s1; cs[((size_t)bi * 3 + 1) * WL + cg] = s2; cs[((size_t)bi * 3 + 2) * WL + cg] = x0; }
        }
    }
    __syncthreads();
    {
        const int rs = wave & 3, chf = wave >> 2, fr = lane & 15, fq = lane >> 4;
        bf16x8 af[4];
#pragma unroll
        for (int kk = 0; kk < 4; ++kk) af[kk] = *(const LAS bf16x8*)(XA + (rs * 16 + fr) * XAS + kk * 32 + fq * 8);
        f32x4 acca[4], accx[4];
#pragma unroll
        for (int ct = 0; ct < 4; ++ct) { acca[ct] = (f32x4){0.f, 0.f, 0.f, 0.f}; accx[ct] = (f32x4){0.f, 0.f, 0.f, 0.f}; }
        const bf16* WaT = (const bf16*)(a.ws + WS_WA) + (size_t)h * 16384; const bf16* WxT = (const bf16*)(a.ws + WS_WX) + (size_t)h * 16384;
#pragma unroll
        for (int ct = 0; ct < 4; ++ct) { const int n = chf * 64 + ct * 16 + fr;
#pragma unroll
            for (int kk = 0; kk < 4; ++kk) { const bf16x8 ba = *(const bf16x8*)(WaT + n * 128 + kk * 32 + fq * 8), bx = *(const bf16x8*)(WxT + n * 128 + kk * 32 + fq * 8);
                acca[ct] = __builtin_amdgcn_mfma_f32_16x16x32_bf16(af[kk], ba, acca[ct], 0, 0, 0); accx[ct] = __builtin_amdgcn_mfma_f32_16x16x32_bf16(af[kk], bx, accx[ct], 0, 0, 0); } }
#pragma unroll
        for (int ct = 0; ct < 4; ++ct) { const int cl = chf * 64 + ct * 16 + fr, cgg = h * 128 + cl;
            const float ba_ = a.in[I_BA][cgg], bx_ = a.in[I_BX][cgg], sp = softplusf_(-a.in[I_LAM][cgg]);
#pragma unroll
            for (int reg = 0; reg < 4; ++reg) { const int t = rs * 16 + fq * 4 + reg;
                const float r = sigmoidf_(acca[ct][reg] + ba_), ig = sigmoidf_(accx[ct][reg] + bx_);
                const float la = -8.0f * r * sp, av = __expf(la);
                const float mult = (!decode && t0 + t == 0) ? 1.0f : sqrtf(-expm1f(2.0f * la));
                const float xc = XC[t * XCS + cl]; XC[t * XCS + cl] = xc * ig * mult; AA[t * XCS + cl] = av; } }
    }
    __syncthreads();
    if (!decode) {
        float hh = 0.f, pp = 1.f;
#pragma unroll 4
        for (int s = 0; s < 16; ++s) { const int t = tq * 16 + s; const float av = AA[t * XCS + c], bv = XC[t * XCS + c]; hh = av * hh + bv; pp *= av; XC[t * XCS + c] = hh; AA[t * XCS + c] = pp; }
        SG[(tq * 128 + c) * 2] = pp; SG[(tq * 128 + c) * 2 + 1] = hh;
        __syncthreads();
        float Ain = 1.f, Bin = 0.f;
        for (int s2 = 0; s2 < tq; ++s2) { const float P = SG[(s2 * 128 + c) * 2], H = SG[(s2 * 128 + c) * 2 + 1]; Bin = P * Bin + H; Ain *= P; }
        float* Acum = a.out + O_ACUM; float* Bcum = a.out + O_BCUM; float ac = 0.f, bc = 0.f;
#pragma unroll 4
        for (int s = 0; s < 16; ++s) { const int t = tq * 16 + s; const float p = AA[t * XCS + c], hl = XC[t * XCS + c]; ac = p * Ain; bc = p * Bin + hl;
            Acum[(rowbase + t) * WL + cg] = ac; Bcum[(rowbase + t) * WL + cg] = bc; }
        if (tq == 3) { ((float*)(a.ws + WS_AGGA))[((size_t)b * 32 + ch) * WL + cg] = ac; ((float*)(a.ws + WS_AGGB))[((size_t)b * 32 + ch) * WL + cg] = bc; }
    } else {
        const float* h0 = a.in[I_SLRU]; float* hs = a.out + O_HS; bf16* Y = (bf16*)(a.ws + WS_H);
#pragma unroll 4
        for (int s = 0; s < 16; ++s) { const int t = tq * 16 + s; const int bi = ch * 64 + t;
            const float hn = AA[t * XCS + c] * h0[(size_t)bi * WL + cg] + XC[t * XCS + c]; hs[(size_t)bi * WL + cg] = hn;
            const float gate = U[(rowbase + t) * NIN + WL + cg]; Y[(rowbase + t) * D + cg] = f2bf(hn * gelu_tanh(gate)); }
    }
    __syncthreads();
}

__device__ __forceinline__ void pool_unit(const Args& a, LAS unsigned char* lds, bool decode, int b, int ch, int g) {
    const int tid = threadIdx.x, lane = tid & 63, wave = __builtin_amdgcn_readfirstlane(tid >> 6);
    LAS float* PU = (LAS float*)lds; LAS bf16* PA = (LAS bf16*)(lds + 80896);
    const float* U = (const float*)(a.ws + WS_U);
    const int c = tid & 255, half = tid >> 8, cgp = g * 256 + c, t0 = ch * 64, w = 2 << g;
    const size_t rowbase = decode ? (size_t)(TP + ch * 64) : (size_t)b * SEQ + t0;
    if (!decode) {
        for (int j = half; j < 79; j += 2) { const int t = j - 15; PU[j * 256 + c] = (t0 + t >= 0) ? U[(rowbase + t) * NIN + 2 * WL + cgp] : 0.f; }
        __syncthreads();
        if (ch == SEQ / 64 - 1) { float* pp = a.out + O_PP + (size_t)b * 15 * WL + cgp; for (int k = half; k < 15; k += 2) pp[(size_t)k * WL] = PU[(64 + k) * 256 + c]; }
        const int ts = half * 32; float S = 0.f;
        for (int i = 0; i < w; ++i) S += PU[(ts + 15 - i) * 256 + c];
        const float invw = 1.0f / (float)w;
#pragma unroll 4
        for (int s = 0; s < 32; ++s) { const int t = ts + s; const int pos = t0 + t; const float cur = PU[(t + 15) * 256 + c];
            const float inv = (pos + 1 >= w) ? invw : 1.0f / (float)(pos + 1);
            PA[t * PAS + c] = f2bf(S * inv - cur);
            if (s < 31) S += PU[(t + 16) * 256 + c] - PU[(t + 16 - w) * 256 + c]; }
    } else {
        const float* sp = a.in[I_SPOOL]; float* ps = a.out + O_PS; const float invw = 1.0f / (float)w;
        for (int s = 0; s < 32; ++s) { const int t = half * 32 + s; const int bi = ch * 64 + t; const float cur = U[(rowbase + t) * NIN + 2 * WL + cgp];
            float S = cur;
#pragma unroll
            for (int k = 0; k < 15; ++k) { const float v = sp[((size_t)bi * 15 + k) * WL + cgp]; if (k >= 16 - w) S += v; if (k >= 1) ps[((size_t)bi * 15 + k - 1) * WL + cgp] = v; }
            ps[((size_t)bi * 15 + 14) * WL + cgp] = cur;
            PA[t * PAS + c] = f2bf(S * invw - cur); }
    }
    __syncthreads();
    {
        const int rs = wave & 3, nh = wave >> 2, fr = lane & 15, fq = lane >> 4;
        bf16x8 af[8];
#pragma unroll
        for (int kk = 0; kk < 8; ++kk) af[kk] = *(const LAS bf16x8*)(PA + (rs * 16 + fr) * PAS + kk * 32 + fq * 8);
        const bf16* WT = (const bf16*)(a.ws + WS_WPOOL) + (size_t)g * 65536; bf16* Y = (bf16*)(a.ws + WS_H); const float* psc = a.in[I_PSCALE];
#pragma unroll 2
        for (int ct = 0; ct < 8; ++ct) { const int n = nh * 128 + ct * 16 + fr; f32x4 acc = (f32x4){0.f, 0.f, 0.f, 0.f};
#pragma unroll
            for (int kk = 0; kk < 8; ++kk) { const bf16x8 wf = *(const bf16x8*)(WT + n * 256 + kk * 32 + fq * 8); acc = __builtin_amdgcn_mfma_f32_16x16x32_bf16(wf, af[kk], acc, 0, 0, 0); }
            const int n4 = nh * 128 + ct * 16 + fq * 4; const f32x4 sc = *(const f32x4*)(psc + g * 256 + n4);
            v2u o; o.x = pk2(acc[0] * sc[0], acc[1] * sc[1]); o.y = pk2(acc[2] * sc[2], acc[3] * sc[3]);
            *(v2u*)(Y + (rowbase + rs * 16 + fr) * D + WL + g * 256 + n4) = o; }
    }
    __syncthreads();
}

__device__ __forceinline__ void phase2(const Args& a, LAS unsigned char* lds, int G) {
    constexpr int N_LP = NB * 32 * 8, N_PP = NB * 32 * 4, N_LD = 2 * 8, N_PD = 2 * 4, NU = N_LP + N_PP + N_LD + N_PD;
    for (int it = blockIdx.x; it < NU; it += G) {
        int r = it;
        if (r < N_PP) { const int g = r & 3, ch = (r >> 2) & 31, b = r >> 7; pool_unit(a, lds, false, b, ch, g); continue; } r -= N_PP;
        if (r < N_LP) { const int h = r & 7, ch = (r >> 3) & 31, b = r >> 8; lru_unit(a, lds, false, b, ch, h); continue; } r -= N_LP;
        if (r < N_LD) { lru_unit(a, lds, true, 0, r >> 3, r & 7); continue; } r -= N_LD;
        pool_unit(a, lds, true, 0, r >> 2, r & 3);
    }
}

__device__ __forceinline__ void phase2b(const Args& a, int G) {
    const int tid = threadIdx.x; const float* U = (const float*)(a.ws + WS_U); bf16* Y = (bf16*)(a.ws + WS_H);
    const float* Acum = a.out + O_ACUM; const float* Bcum = a.out + O_BCUM; const float* AggA = (const float*)(a.ws + WS_AGGA); const float* AggB = (const float*)(a.ws + WS_AGGB);
    for (int it = blockIdx.x; it < NB * 32 * 2; it += G) {
        const int rh = it & 1, ch = (it >> 1) & 31, b = it >> 6, c2 = tid * 2;
        f32x2 carry = (f32x2){0.f, 0.f};
#pragma unroll
        for (int k = 0; k < 31; ++k) { const f32x2 A = *(const f32x2*)(AggA + ((size_t)b * 32 + k) * WL + c2), B = *(const f32x2*)(AggB + ((size_t)b * 32 + k) * WL + c2); const f32x2 nc = A * carry + B; carry = (k < ch) ? nc : carry; }
        const size_t row0 = (size_t)b * SEQ + ch * 64 + rh * 32; f32x2 hlast = (f32x2){0.f, 0.f};
#pragma unroll 4
        for (int r = 0; r < 32; ++r) { const size_t row = row0 + r;
            const f32x2 A = *(const f32x2*)(Acum + row * WL + c2), B = *(const f32x2*)(Bcum + row * WL + c2), gt = *(const f32x2*)(U + row * NIN + WL + c2);
            const f32x2 hv = A * carry + B; hlast = hv;
            *(unsigned*)(Y + row * D + c2) = pk2(hv.x * gelu_tanh(gt.x), hv.y * gelu_tanh(gt.y)); }
        if (ch == 31 && rh == 1) *(f32x2*)(a.out + O_HP + (size_t)b * WL + c2) = hlast;
    }
}

__device__ __forceinline__ void phase6(const Args& a, int G) {
    const int tid = threadIdx.x, lane = tid & 63, wave = tid >> 6; const float* rsq = (const float*)(a.ws + WS_RSQ2);
    const f32x4* gr = (const f32x4*)a.in[I_GFIN] + lane;
    for (int m = blockIdx.x * NWAVES + wave; m < MTOT; m += G * NWAVES) {
        const float rstd = 1.0f / sqrtf(wave_sum(lane < 32 ? rsq[(size_t)m * 32 + lane] : 0.f) * (1.0f / D) + EPS);
        f32x4* xr = (f32x4*)(a.out + O_Y + (size_t)m * D) + lane;
#pragma unroll
        for (int j = 0; j < 8; ++j) { const f32x4 g = gr[64 * j]; xr[64 * j] = xr[64 * j] * rstd * g; }
    }
}

__global__ void __launch_bounds__(NWAVES * 64, 2) hymba_fwd(Args args) {
    extern __shared__ __attribute__((aligned(16))) unsigned char lds_raw[];
    LAS unsigned char* lds = (LAS unsigned char*)lds_raw;
    const int tid = threadIdx.x, G = gridDim.x;
    unsigned char* ws = args.ws;
    unsigned* ctl = (unsigned*)(ws + WS_CTL);
    for (int u = tid; u < (LDS_BYTES - LDSCTL_OFF) / 4; u += NWAVES * 64) ((LAS unsigned*)(lds + LDSCTL_OFF))[u] = 0u;
    __syncthreads();
    XcdBarrier bar; bar.bar = ctl + CW_BAR; bar.x = 0; bar.st = nullptr;
    if (MK_N_LAUNCHES == 1) bar = xcd_barrier_post(ctl + CW_BAR, (volatile LAS unsigned*)(lds + LDSCTL_OFF + 64));
    const int lo = args.ph_lo, hi = args.ph_hi;
#define IN(k) (lo <= (k) && (k) < hi)
#define SEAM(k) do { if (IN(k) && IN((k) + 1)) xcd_barrier(bar); } while (0)
    float* rsq1 = (float*)(ws + WS_RSQ1); float* rsq2 = (float*)(ws + WS_RSQ2);
    if (IN(0)) { phase0(args, lds, G); } SEAM(0);
    if (IN(1)) {
        pg8::Gemm g{(const pg8::bf16_t*)(ws + WS_H), (const pg8::bf16_t*)(ws + WS_WIN), MP, NIN, D}; pg8::StaticOrder S; S.init(MP, NIN, G, (int)blockIdx.x);
        pg8::EpiU E{(float*)(ws + WS_U), NIN};
        pg8::gemm_phase<pg8::EpiU, pg8::StaticOrder, true, true>(lds, g, S, E);
    } SEAM(1);
    if (IN(2)) { phase2(args, lds, G); } SEAM(2);
    if (IN(3)) { phase2b(args, G); } SEAM(3);
    if (IN(4)) {
        pg8::Gemm g{(const pg8::bf16_t*)(ws + WS_H), (const pg8::bf16_t*)(ws + WS_WOUT), MP, D, D}; pg8::StaticOrder S; S.init(MP, D, G, (int)blockIdx.x);
        pg8::EpiOut E{args.in[I_XP], args.in[I_XS], args.out + O_Y, (pg8::bf16_t*)(ws + WS_X1B), rsq1};
        pg8::gemm_phase<pg8::EpiOut, pg8::StaticOrder, true, true>(lds, g, S, E);
    } SEAM(4);
    if (IN(5)) {
        pg8::Gemm g{(const pg8::bf16_t*)(ws + WS_X1B), (const pg8::bf16_t*)(ws + WS_WUP), MP, FF, D}; pg8::StaticOrder S; S.init(MP, FF, G, (int)blockIdx.x);
        pg8::EpiUp E{(pg8::bf16_t*)(ws + WS_F), rsq1};
        pg8::gemm_phase<pg8::EpiUp, pg8::StaticOrder, true, true>(lds, g, S, E);
    } SEAM(5);
    if (IN(6)) {
        pg8::Gemm g{(const pg8::bf16_t*)(ws + WS_F), (const pg8::bf16_t*)(ws + WS_WDOWN), MP, D, FF}; pg8::StaticOrder S; S.init(MP, D, G, (int)blockIdx.x);
        pg8::EpiDown E{args.out + O_Y, rsq2};
        pg8::gemm_phase<pg8::EpiDown, pg8::StaticOrder, true, true>(lds, g, S, E);
    } SEAM(6);
    if (IN(7)) { phase6(args, G); }
#undef IN
#undef SEAM
}

extern "C" void kernel_launch(void* const* d_in, const int* in_sizes, int n_in, void* d_out, int out_size, void* d_ws, size_t ws_size, hipStream_t stream) {
    static int grid = 0;
    if (grid == 0) {
        if (n_in != 21 || (size_t)out_size != O_END || ws_size < WS_END) { fprintf(stderr, "kernel_launch: unexpected shapes: n_in %d out %d ws %zu\n", n_in, out_size, ws_size); grid = -1; return; }
        int dev = 0, cus = 0, per_cu = 0;
        if (hipGetDevice(&dev) != hipSuccess || hipDeviceGetAttribute(&cus, hipDeviceAttributeMultiprocessorCount, dev) != hipSuccess) { grid = -1; return; }
        if (hipFuncSetAttribute((const void*)hymba_fwd, hipFuncAttributeMaxDynamicSharedMemorySize, LDS_BYTES) != hipSuccess) { fprintf(stderr, "kernel_launch: hipFuncSetAttribute failed\n"); grid = -1; return; }
        if (hipOccupancyMaxActiveBlocksPerMultiprocessor(&per_cu, (const void*)hymba_fwd, NWAVES * 64, LDS_BYTES) != hipSuccess || per_cu < 1) { fprintf(stderr, "kernel_launch: occupancy query says %d\n", per_cu); per_cu = 1; }
        (void)hipGetLastError();
        grid = cus;
    }
    if (grid < 0) return;
    (void)hipMemsetAsync((char*)d_ws + WS_CTL, 0, CTL_ZERO_BYTES, stream);
    Args a{};
    for (int i = 0; i < 21; ++i) a.in[i] = (const float*)d_in[i];
    a.out = (float*)d_out; a.ws = (unsigned char*)d_ws;
#if MK_N_LAUNCHES == 1
    a.ph_lo = 0; a.ph_hi = NPHASE;
    void* kargs[] = {&a};
    hipError_t e = hipLaunchCooperativeKernel((const void*)hymba_fwd, dim3(grid), dim3(NWAVES * 64), kargs, LDS_BYTES, stream);
    if (e != hipSuccess) fprintf(stderr, "kernel_launch: cooperative launch failed: %s (grid %d)\n", hipGetErrorString(e), grid);
#else
    for (int p = 0; p < NPHASE; ++p) { a.ph_lo = p; a.ph_hi = p + 1; hipLaunchKernelGGL(hymba_fwd, dim3(grid), dim3(NWAVES * 64), LDS_BYTES, stream, a); }
#endif
}
```

```cpp
#include <hip/hip_runtime.h>
#include <cstdio>
#include <cstdint>
namespace pg8 {
#define PG8_LAS __attribute__((address_space(3)))
typedef unsigned short bf16_t;
typedef short bf16x8 __attribute__((ext_vector_type(8)));
typedef float f32x4 __attribute__((ext_vector_type(4)));
typedef unsigned u32x4 __attribute__((ext_vector_type(4)));
constexpr int BM = 256, BK = 64, HALF = 128, HTB = HALF * BK * 2  , STAGE_BYTES = 8 * HTB, NXCD = 8, WGM = 8;

__host__ __device__ __forceinline__ int lds_byte(int r, int c) { const int st = (r >> 4) * 2 + (c >> 5), rr = r & 15, cc = c & 31, ob = rr * 64 + cc * 2; return st * 1024 + (ob ^ (((ob >> 9) & 1) << 5)); }
__host__ __device__ __forceinline__ void stage_rc(int b, int& R, int& C) { const int st = b / 1024, sb = b % 1024, swz = sb ^ (((sb >> 9) & 1) << 5); R = (st >> 1) * 16 + swz / 64; C = (st & 1) * 32 + (swz % 64) / 2; }
__host__ __device__ __forceinline__ int perm32(int rho) { const int n = rho >> 4, i = rho & 15; return 8 * (i >> 2) + 4 * n + (i & 3); }

struct Unit { int pm, pn; };
struct Gemm { const bf16_t* A; const bf16_t* Bt; int M, N, K; };

struct StaticOrder {
    int nM, nN, nwg, G, c;
    __host__ __device__ void init(int M, int N, int G_, int c_) { nM = M / BM; nN = N / BM; nwg = nM * nN; G = G_; c = c_; }
    __host__ __device__ bool next(int i, Unit& u) const {
        const long L = (long)i * G + c; if (L >= nwg) return false;
        int wgid = (int)L; { const int q = nwg / NXCD, r = nwg % NXCD, xcd = wgid % NXCD, off = wgid / NXCD; wgid = (xcd < r ? xcd * (q + 1) : r * (q + 1) + (xcd - r) * q) + off; }
        const int nig = WGM * nN, gid = wgid / nig, fm = gid * WGM, gsz = (nM - fm) < WGM ? (nM - fm) : WGM;
        u.pm = fm + ((wgid % nig) % gsz); u.pn = (wgid % nig) / gsz; return true;
    }
    __device__ __forceinline__ void a_ready(const Unit&) const {}
    __device__ __forceinline__ void done(const Unit&) const {}
};

__device__ __forceinline__ unsigned cvt_pk_bf16(float lo, float hi) { unsigned r; asm volatile("v_cvt_pk_bf16_f32 %0, %1, %2" : "=v"(r) : "v"(lo), "v"(hi)); return r; }
typedef float f32x2 __attribute__((ext_vector_type(2)));
constexpr int E_D = 2048, E_TP = 8192, E_M = 8320, E_FF = 8192;
constexpr float E_EPS = 1e-6f;
__device__ __forceinline__ float dot4(const f32x4 v) { return (v[0] * v[0] + v[1] * v[1]) + (v[2] * v[2] + v[3] * v[3]); }

struct EpiU {
    static constexpr bool PERM = false, AFTER_DRAIN = false;
    float* C; int ldc;
    __device__ __forceinline__ void operator()(const f32x4 (&acc)[2][2][4][2], const Unit& u, int wr, int wc, int fr, int fq) const {
        const int row0 = u.pm * BM + wr * 64 + fr, col0 = u.pn * BM + wc * 32 + 4 * fq;
#pragma unroll
        for (int ai = 0; ai < 2; ++ai)
#pragma unroll
            for (int m = 0; m < 4; ++m) { const int row = row0 + ai * HALF + m * 16;
                if (row < E_M) { float* rowp = C + (size_t)row * ldc + col0;
#pragma unroll
                    for (int bj = 0; bj < 2; ++bj)
#pragma unroll
                        for (int n = 0; n < 2; ++n) *(f32x4*)(rowp + bj * HALF + n * 16) = acc[ai][bj][m][n]; } }
    }
};
struct EpiOut {
    static constexpr bool PERM = true, AFTER_DRAIN = false;
    const float* xp; float* X1; bf16_t* X1b; float* rowsq;
    __device__ __forceinline__ void operator()(const f32x4 (&acc)[2][2][4][2], const Unit& u, int wr, int wc, int fr, int fq) const {
        const int row0 = u.pm * BM + wr * 64 + fr, col0 = u.pn * BM + wc * 32 + 8 * fq;
#pragma unroll
        for (int ai = 0; ai < 2; ++ai)
#pragma unroll
            for (int m = 0; m < 4; ++m) { const int row = row0 + ai * HALF + m * 16;
                {
                    const float* xr = xp + (size_t)row * E_D + col0;
                    float* o1 = X1 + (size_t)row * E_D + col0; bf16_t* ob = X1b + (size_t)row * E_D + col0; float ss = 0.f;
#pragma unroll
                    for (int bj = 0; bj < 2; ++bj) {
                        const f32x4 v0 = acc[ai][bj][m][0] + *(const f32x4*)(xr + bj * HALF), v1 = acc[ai][bj][m][1] + *(const f32x4*)(xr + bj * HALF + 4);
                        *(f32x4*)(o1 + bj * HALF) = v0; *(f32x4*)(o1 + bj * HALF + 4) = v1; ss += dot4(v0) + dot4(v1);
                        u32x4 w; w.x = cvt_pk_bf16(v0[0], v0[1]); w.y = cvt_pk_bf16(v0[2], v0[3]); w.z = cvt_pk_bf16(v1[0], v1[1]); w.w = cvt_pk_bf16(v1[2], v1[3]);
                        *(u32x4*)(ob + bj * HALF) = w; }
                    ss += __shfl_xor(ss, 16); ss += __shfl_xor(ss, 32);
                    if (fq == 0) rowsq[(size_t)row * 32 + u.pn * 4 + wc] = ss; } }
    }
};
struct EpiUp {
    static constexpr bool PERM = true, AFTER_DRAIN = false;
    bf16_t* F; const float* rowsq;
    __device__ __forceinline__ void operator()(const f32x4 (&acc)[2][2][4][2], const Unit& u, int wr, int wc, int fr, int fq) const {
        const int row0 = u.pm * BM + wr * 64 + fr, col0 = u.pn * BM + wc * 32 + 8 * fq;
#pragma unroll
        for (int ai = 0; ai < 2; ++ai)
#pragma unroll
            for (int m = 0; m < 4; ++m) { const int row = row0 + ai * HALF + m * 16;
                float s = 0.f;
                { const float* rp = rowsq + (size_t)row * 32 + fq * 8; const f32x4 p0 = *(const f32x4*)rp, p1 = *(const f32x4*)(rp + 4);
                    float t = ((p0[0] + p0[1]) + (p0[2] + p0[3])) + ((p1[0] + p1[1]) + (p1[2] + p1[3])); t += __shfl_xor(t, 16); t += __shfl_xor(t, 32);
                    s = 1.0f / sqrtf(t * (1.0f / E_D) + E_EPS); }
                bf16_t* ob = F + (size_t)row * E_FF + col0;
#pragma unroll
                for (int bj = 0; bj < 2; ++bj) {
                    f32x4 v0 = acc[ai][bj][m][0] * s, v1 = acc[ai][bj][m][1] * s;
#pragma unroll
                    for (int j = 0; j < 4; ++j) { const float a = fmaxf(v0[j], 0.f), b = fmaxf(v1[j], 0.f); v0[j] = a * a; v1[j] = b * b; }
                    u32x4 w; w.x = cvt_pk_bf16(v0[0], v0[1]); w.y = cvt_pk_bf16(v0[2], v0[3]); w.z = cvt_pk_bf16(v1[0], v1[1]); w.w = cvt_pk_bf16(v1[2], v1[3]);
                    *(u32x4*)(ob + bj * HALF) = w; } }
    }
};
struct EpiDown {
    static constexpr bool PERM = false, AFTER_DRAIN = false;
    float* X; float* rowsq;
    __device__ __forceinline__ void operator()(const f32x4 (&acc)[2][2][4][2], const Unit& u, int wr, int wc, int fr, int fq) const {
        const int row0 = u.pm * BM + wr * 64 + fr, col0 = u.pn * BM + wc * 32 + 4 * fq;
#pragma unroll
        for (int ai = 0; ai < 2; ++ai)
#pragma unroll
            for (int m = 0; m < 4; ++m) { const int row = row0 + ai * HALF + m * 16;
                { float* rowp = X + (size_t)row * E_D + col0; float ss = 0.f;
#pragma unroll
                    for (int bj = 0; bj < 2; ++bj)
#pragma unroll
                        for (int n = 0; n < 2; ++n) { const f32x4 v = acc[ai][bj][m][n] + *(const f32x4*)(rowp + bj * HALF + n * 16); *(f32x4*)(rowp + bj * HALF + n * 16) = v; ss += dot4(v); }
                    ss += __shfl_xor(ss, 16); ss += __shfl_xor(ss, 32);
                    if (fq == 0) rowsq[(size_t)row * 32 + u.pn * 4 + wc] = ss; } }
    }
};

template <class Epi, class Sched, bool ALIGN_EPI = false, bool SP2 = false>
__device__ __forceinline__ void gemm_phase(PG8_LAS unsigned char* lds, const Gemm g, const Sched& S, const Epi& E) {
    const int tid = threadIdx.x, wid = __builtin_amdgcn_readfirstlane(tid >> 6), lane = tid & 63, wr = wid >> 2, wc = wid & 3, fr = lane & 15, fq = lane >> 4;
    const int K = g.K, nt = K / BK;
    unsigned voffA[2], voffB[2];
#pragma unroll
    for (int i = 0; i < 2; ++i) { int R, C; stage_rc(tid * 16 + i * 8192, R, C); const int Rb = Epi::PERM ? ((R & ~31) + perm32(R & 31)) : R;
        voffA[i] = (unsigned)(R * K + C) * 2u; voffB[i] = (unsigned)(Rb * K + C) * 2u; }
    const size_t kstep = (size_t)(BK * 2);
    const size_t hstep = (size_t)HALF * K * 2;
    const size_t tstep = 2 * hstep;
    const unsigned ldsw = (unsigned)wid * 1024u;
    const int aoff = lds_byte(wr * 64 + fr, fq * 8), boff = lds_byte(wc * 32 + fr, fq * 8);
#define PG8_SA(b, h) (((b) * 2 + (h)) * HTB)
#define PG8_SB(b, h) ((4 + (b) * 2 + (h)) * HTB)
#define PG8_STAGE(bufoff, gbase, voff) do { _Pragma("unroll") for (int _i = 0; _i < 2; ++_i) \
        __builtin_amdgcn_global_load_lds((const unsigned*)((const char*)(gbase) + (voff)[_i]), (PG8_LAS unsigned*)(lds + (bufoff) + ldsw + _i * 8192), 16, 0, 0); } while (0)
#define PG8_LDA(dst, b, h) do { _Pragma("unroll") for (int m = 0; m < 4; ++m) _Pragma("unroll") for (int k = 0; k < 2; ++k) dst[m][k] = *(const PG8_LAS bf16x8*)(lds + PG8_SA(b, h) + aoff + m * 2048 + k * 1024); } while (0)
#define PG8_LDB(dst, b, h) do { _Pragma("unroll") for (int n = 0; n < 2; ++n) _Pragma("unroll") for (int k = 0; k < 2; ++k) dst[n][k] = *(const PG8_LAS bf16x8*)(lds + PG8_SB(b, h) + boff + n * 2048 + k * 1024); } while (0)
#define PG8_MMA(ai, bj, At, Bt) do { __builtin_amdgcn_s_setprio(1); _Pragma("unroll") for (int m = 0; m < 4; ++m) _Pragma("unroll") for (int n = 0; n < 2; ++n) _Pragma("unroll") for (int k = 0; k < 2; ++k) \
        acc[ai][bj][m][n] = __builtin_amdgcn_mfma_f32_16x16x32_bf16(Bt[n][k], At[m][k], acc[ai][bj][m][n], 0, 0, 0); __builtin_amdgcn_s_setprio(0); } while (0)
#define PG8_WAIT_V(n) asm volatile("s_waitcnt vmcnt(" #n ")" ::: "memory")
#define PG8_WAIT_L(n) asm volatile("s_waitcnt lgkmcnt(" #n ")" ::: "memory")
#define PG8_BAR __builtin_amdgcn_s_barrier()
#define PG8_SCHED __builtin_amdgcn_sched_barrier(0)
    Unit cur, nxt; int ui = 0;
    if (!S.next(0, cur)) return;
    f32x4 acc[2][2][4][2];
#pragma unroll
    for (int a = 0; a < 2; ++a)
#pragma unroll
        for (int b = 0; b < 2; ++b)
#pragma unroll
            for (int m = 0; m < 4; ++m)
#pragma unroll
                for (int n = 0; n < 2; ++n) acc[a][b][m][n] = (f32x4){0.f, 0.f, 0.f, 0.f};
    bf16x8 At[4][2], B0[2][2], B1[2][2];
    const char* cA = (const char*)g.A + (size_t)cur.pm * tstep; const char* cB = (const char*)g.Bt + (size_t)cur.pn * tstep;
    S.a_ready(cur);
    if constexpr (SP2) {
        PG8_STAGE(PG8_SB(0, 0), cB, voffB); PG8_STAGE(PG8_SB(0, 1), cB + hstep, voffB); PG8_STAGE(PG8_SA(0, 0), cA, voffA); PG8_STAGE(PG8_SA(0, 1), cA + hstep, voffA);
        if (wr == 1) PG8_BAR;
        PG8_WAIT_V(2); PG8_BAR;
        PG8_STAGE(PG8_SB(1, 0), cB + kstep, voffB); PG8_STAGE(PG8_SA(1, 0), cA + kstep, voffA); PG8_STAGE(PG8_SB(1, 1), cB + hstep + kstep, voffB);
        PG8_WAIT_V(6); PG8_BAR;
    } else {
        PG8_STAGE(PG8_SB(0, 0), cB, voffB); PG8_STAGE(PG8_SA(0, 0), cA, voffA); PG8_STAGE(PG8_SB(0, 1), cB + hstep, voffB); PG8_STAGE(PG8_SA(0, 1), cA + hstep, voffA);
        if (wr == 1) PG8_BAR;
        PG8_WAIT_V(4); PG8_BAR;
        PG8_STAGE(PG8_SB(1, 0), cB + kstep, voffB); PG8_STAGE(PG8_SA(1, 0), cA + kstep, voffA); PG8_STAGE(PG8_SB(1, 1), cB + hstep + kstep, voffB);
        PG8_WAIT_V(6); PG8_BAR;
    }
    for (;;) {
        const bool has_next = S.next(ui + 1, nxt);
        const char* nA = has_next ? (const char*)g.A + (size_t)nxt.pm * tstep : cA; const char* nB = has_next ? (const char*)g.Bt + (size_t)nxt.pn * tstep : cB;
        for (int t = 0; t < nt; t += 2) {
            const bool last = (t == nt - 2);
            const char* a1 = cA + (size_t)(t + 1) * kstep;
            const char* a2 = last ? nA : cA + (size_t)(t + 2) * kstep; const char* b2 = last ? nB : cB + (size_t)(t + 2) * kstep;
            const char* a3 = a2 + kstep; const char* b3 = b2 + kstep;
            if (last && has_next) S.a_ready(nxt);
            if constexpr (SP2) {
            PG8_LDB(B0, 0, 0); PG8_LDB(B1, 0, 1); PG8_SCHED; PG8_LDA(At, 0, 0); PG8_STAGE(PG8_SA(1, 1), a1 + hstep, voffA);
            PG8_WAIT_V(8); PG8_WAIT_L(0); PG8_BAR; PG8_MMA(0, 0, At, B0); PG8_MMA(0, 1, At, B1); PG8_BAR; PG8_SCHED;
            PG8_LDA(At, 0, 1); PG8_STAGE(PG8_SB(0, 0), b2, voffB); PG8_STAGE(PG8_SB(0, 1), b2 + hstep, voffB); PG8_STAGE(PG8_SA(0, 0), a2, voffA);
            PG8_WAIT_V(8); PG8_WAIT_L(0); PG8_BAR; PG8_MMA(1, 0, At, B0); PG8_MMA(1, 1, At, B1); PG8_BAR; PG8_SCHED;
            PG8_LDB(B0, 1, 0); PG8_LDB(B1, 1, 1); PG8_SCHED; PG8_LDA(At, 1, 0); PG8_STAGE(PG8_SA(0, 1), a2 + hstep, voffA);
            PG8_WAIT_V(8); PG8_WAIT_L(0); PG8_BAR; PG8_MMA(0, 0, At, B0); PG8_MMA(0, 1, At, B1); PG8_BAR; PG8_SCHED;
            PG8_LDA(At, 1, 1); PG8_STAGE(PG8_SB(1, 0), b3, voffB); PG8_STAGE(PG8_SB(1, 1), b3 + hstep, voffB); PG8_STAGE(PG8_SA(1, 0), a3, voffA);
            PG8_WAIT_V(8); PG8_WAIT_L(0); PG8_BAR; PG8_MMA(1, 0, At, B0); PG8_MMA(1, 1, At, B1); PG8_BAR; PG8_SCHED;
            } else {
            PG8_LDB(B0, 0, 0); PG8_SCHED; PG8_LDA(At, 0, 0); PG8_STAGE(PG8_SA(1, 1), a1 + hstep, voffA);
            PG8_WAIT_L(8); PG8_BAR; PG8_WAIT_L(0); PG8_MMA(0, 0, At, B0); PG8_BAR; PG8_SCHED;
            PG8_LDB(B1, 0, 1); PG8_STAGE(PG8_SB(0, 0), b2, voffB);
            PG8_BAR; PG8_WAIT_L(0); PG8_MMA(0, 1, At, B1); PG8_BAR;
            PG8_LDA(At, 0, 1); PG8_STAGE(PG8_SA(0, 0), a2, voffA);
            PG8_BAR; PG8_WAIT_L(0); PG8_MMA(1, 0, At, B0); PG8_BAR; PG8_SCHED;
            PG8_STAGE(PG8_SB(0, 1), b2 + hstep, voffB);
            PG8_WAIT_V(6); PG8_BAR; PG8_MMA(1, 1, At, B1); PG8_BAR;
            PG8_LDB(B0, 1, 0); PG8_SCHED; PG8_LDA(At, 1, 0); PG8_STAGE(PG8_SA(0, 1), a2 + hstep, voffA);
            PG8_WAIT_L(8); PG8_BAR; PG8_WAIT_L(0); PG8_MMA(0, 0, At, B0); PG8_BAR; PG8_SCHED;
            PG8_LDB(B1, 1, 1); PG8_STAGE(PG8_SB(1, 0), b3, voffB);
            PG8_BAR; PG8_WAIT_L(0); PG8_MMA(0, 1, At, B1); PG8_BAR;
            PG8_LDA(At, 1, 1); PG8_STAGE(PG8_SA(1, 0), a3, voffA);
            PG8_BAR; PG8_WAIT_L(0); PG8_MMA(1, 0, At, B0); PG8_BAR; PG8_SCHED;
            PG8_STAGE(PG8_SB(1, 1), b3 + hstep, voffB);
            PG8_WAIT_V(6); PG8_BAR; PG8_MMA(1, 1, At, B1); PG8_BAR;
            }
        }
        if constexpr (ALIGN_EPI) { if (wr == 0) PG8_BAR; }
        if constexpr (!Epi::AFTER_DRAIN) { E(acc, cur, wr, wc, fr, fq); S.done(cur); }
        if (!has_next) break;
#pragma unroll
        for (int a = 0; a < 2; ++a)
#pragma unroll
            for (int b = 0; b < 2; ++b)
#pragma unroll
                for (int m = 0; m < 4; ++m)
#pragma unroll
                    for (int n = 0; n < 2; ++n) acc[a][b][m][n] = (f32x4){0.f, 0.f, 0.f, 0.f};
        cur = nxt; cA = nA; cB = nB; ++ui;
        if constexpr (ALIGN_EPI) { if (wr == 1) PG8_BAR; }
    }
    PG8_WAIT_V(0);
    if constexpr (!ALIGN_EPI) { if (wr == 0) PG8_BAR; }
    PG8_BAR;
    if constexpr (Epi::AFTER_DRAIN) { E.fused(acc, cur, wr, wc, fr, fq, lds, wid, lane); S.done(cur); }
#undef PG8_SA
#undef PG8_SB
#undef PG8_STAGE
#undef PG8_LDA
#undef PG8_LDB
#undef PG8_MMA
#undef PG8_WAIT_V
#undef PG8_WAIT_L
#undef PG8_BAR
#undef PG8_SCHED
}
}
#ifndef MK_N_LAUNCHES
#define MK_N_LAUNCHES 1
#endif
constexpr int NWAVES = 8, NPHASE = 8;
constexpr int D = 2048, TP = 8192, TS = 128, MTOT = 8320, MP = 8448, SEQ = 2048, NB = 4, NIN = 3072, WL = 1024, FF = 8192;
constexpr float EPS = 1e-6f;
constexpr size_t MiB = 1u << 20;
constexpr size_t WS_CTL = 0, CTL_ZERO_BYTES = 1 * MiB;
constexpr size_t WS_WUP = 1 * MiB, WS_WDOWN = 33 * MiB, WS_WIN = 65 * MiB, WS_WOUT = 77 * MiB, WS_WA = 85 * MiB, WS_WX = WS_WA + 256 * 1024, WS_WPOOL = WS_WA + 512 * 1024;
constexpr size_t WS_H = 86 * MiB;
constexpr size_t WS_U = 119 * MiB;
constexpr size_t WS_X1B = 197 * MiB;
constexpr size_t WS_F = 65 * MiB;
constexpr size_t WS_AGGA = 231 * MiB, WS_AGGB = 232 * MiB;
constexpr size_t WS_END = 256 * MiB;
static_assert(WS_F + (size_t)MP * FF * 2 <= WS_X1B && WS_X1B + (size_t)MP * D * 2 <= WS_AGGA && WS_U + (size_t)MTOT * NIN * 4 <= WS_AGGA, "d_ws map");
constexpr int CW_BAR = 4096;
constexpr size_t WS_RSQ1 = 233 * MiB, WS_RSQ2 = 235 * MiB;
constexpr size_t WS_RSQD1 = 236 * MiB;
constexpr size_t WS_FD = 237 * MiB;
constexpr size_t WS_PD = 239 * MiB;
constexpr size_t O_Y = 0, O_HP = 17039360, O_CP = 17043456, O_PP = 17055744, O_HS = 17117184, O_CS = 17248256, O_PS = 17641472, O_END = 19607552;
constexpr size_t O_ACUM = 0, O_BCUM = 8388608;
constexpr int RING_BYTES = 131072, LDSCTL_OFF = RING_BYTES, LDS_BYTES = 147456;

#define LAS __attribute__((address_space(3)))
typedef unsigned short bf16;
typedef unsigned v4u __attribute__((ext_vector_type(4)));
typedef unsigned v2u __attribute__((ext_vector_type(2)));
typedef float f32x4 __attribute__((ext_vector_type(4)));
typedef float f32x2 __attribute__((ext_vector_type(2)));
typedef short bf16x8 __attribute__((ext_vector_type(8)));
#define LDS_WAIT() asm volatile("s_waitcnt lgkmcnt(0)" ::: "memory")
__device__ __forceinline__ unsigned pk2(float lo, float hi) { return pg8::cvt_pk_bf16(lo, hi); }
__device__ __forceinline__ bf16 f2bf(float f) { return (bf16)(pg8::cvt_pk_bf16(f, 0.f) & 0xffffu); }
__device__ __forceinline__ float sigmoidf_(float x) { return 1.0f / (1.0f + __expf(-x)); }
__device__ __forceinline__ float gelu_tanh(float x) { const float z = 0.7978845608028654f * (x + 0.044715f * x * x * x); const float t = 1.0f - 2.0f / (1.0f + __expf(2.0f * z)); return 0.5f * x * (1.0f + t); }

#define XB_TMO      128
#define XB_XCNT(j)  (256  + 64 * (j))
#define XB_XSUB(j)  (1280 + 64 * (j))
#define XB_XGEN(j)  (2304 + 64 * (j))
#define XB_TOP      3328
#define XB_TOPGEN   3392
#define XCD_BAR_WORDS 3456
#define XB_SPIN_CAP (1u << 18)

__device__ __forceinline__ unsigned xb_ld(unsigned* p)              { return __hip_atomic_load(p, __ATOMIC_RELAXED, __HIP_MEMORY_SCOPE_AGENT); }
__device__ __forceinline__ unsigned xb_add(unsigned* p, unsigned v) { return __hip_atomic_fetch_add(p, v, __ATOMIC_RELAXED, __HIP_MEMORY_SCOPE_AGENT); }
__device__ __forceinline__ unsigned xb_xcc_id() { return (unsigned)__builtin_amdgcn_s_getreg((3 << 11) | 20) & 0xFu; }
#define XB_SPIN(cond, bar) do { unsigned _sp = 0; while (cond) { __builtin_amdgcn_s_sleep(1); \
    if ((++_sp & 255u) == 0u) { if (xb_ld(&(bar)[XB_TMO])) break; if (_sp > XB_SPIN_CAP) { atomicAdd(&(bar)[XB_TMO], 1u); break; } } } } while (0)

struct XcdBarrier {
    unsigned* bar; unsigned x;
    volatile LAS unsigned* st;
};

__device__ __forceinline__ XcdBarrier xcd_barrier_post(unsigned* bar, volatile LAS unsigned* st) {
    XcdBarrier b; b.bar = bar; b.x = xb_xcc_id(); b.st = st;
    if (threadIdx.x == 0) (void)xb_add(&bar[XB_XCNT(b.x)], 1u);
    return b;
}
__device__ __forceinline__ void xcd_barrier_complete(unsigned* bar, unsigned x, unsigned& nloc, unsigned& nx) {
    const unsigned G = gridDim.x * gridDim.y * gridDim.z;
    unsigned sum, cnt, mine, sp = 0u;
    for (;;) {
        sum = 0u; cnt = 0u; mine = 0u;
#pragma unroll
        for (unsigned j = 0; j < 16; ++j) { const unsigned c = xb_ld(&bar[XB_XCNT(j)]); sum += c; cnt += (c > 0u) ? 1u : 0u; mine = (j == x) ? c : mine; }
        if (sum == G) break;
        __builtin_amdgcn_s_sleep(1);
        if ((++sp & 255u) == 0u) { if (xb_ld(&bar[XB_TMO])) break; if (sp > XB_SPIN_CAP) { atomicAdd(&bar[XB_TMO], 1u); break; } }
    }
    nloc = mine > 0u ? mine : 1u; nx = cnt > 0u ? cnt : 1u;
}

__device__ __forceinline__ void xcd_barrier(const XcdBarrier& b) {
    asm volatile("s_waitcnt vmcnt(0)" ::: "memory");
    __syncthreads();
    if (threadIdx.x == 0) {
        unsigned* bar = b.bar;
        __builtin_amdgcn_s_waitcnt(0);
        unsigned nloc = b.st[0], nx = b.st[1];
        if (nloc == 0u) { xcd_barrier_complete(bar, b.x, nloc, nx); b.st[0] = nloc; b.st[1] = nx; }
        const unsigned old = xb_add(&bar[XB_XSUB(b.x)], 1u);
        const unsigned gen = old / nloc;
        if (old + 1u == (gen + 1u) * nloc) {
            __builtin_amdgcn_fence(__ATOMIC_RELEASE, "agent");
            asm volatile("s_waitcnt vmcnt(0)" ::: "memory");
            const unsigned og = xb_add(&bar[XB_TOP], 1u);
            const unsigned tg = og / nx;
            if (og + 1u == (tg + 1u) * nx) xb_add(&bar[XB_TOPGEN], 1u);
            else XB_SPIN(xb_ld(&bar[XB_TOPGEN]) == tg, bar);
            __builtin_amdgcn_fence(__ATOMIC_ACQUIRE, "agent");
            xb_add(&bar[XB_XGEN(b.x)], 1u);
            asm volatile("s_waitcnt vmcnt(0)" ::: "memory");
        } else {
            XB_SPIN(xb_ld(&bar[XB_XGEN(b.x)]) == gen, bar);
            __builtin_amdgcn_fence(__ATOMIC_ACQUIRE, "agent");
            asm volatile("s_waitcnt vmcnt(0)" ::: "memory");
        }
    }
    __syncthreads();
}
template <class Epi>
__device__ __forceinline__ void dec_gemm_unit(LAS unsigned char* lds, const bf16* A, int lda, const bf16* W, int ldw, int n0, const Epi& E) {
    const int tid = threadIdx.x, lane = tid & 63, wave = __builtin_amdgcn_readfirstlane(tid >> 6), fr = lane & 15, fq = lane >> 4, sg = wave >> 2, kq = wave & 3;
    const bf16* ap = A + (size_t)(sg * 64 + fr) * lda + kq * 512 + fq * 8;
    const bf16* wp = W + (size_t)(n0 + fr) * ldw + kq * 512 + fq * 8;
    f32x4 acc[4][2];
#pragma unroll
    for (int s = 0; s < 4; ++s) { acc[s][0] = (f32x4){0.f, 0.f, 0.f, 0.f}; acc[s][1] = (f32x4){0.f, 0.f, 0.f, 0.f}; }
    bf16x8 ar[4][4], br[4][2];
#define DG_LOAD(slot, j) do { _Pragma("unroll") for (int s = 0; s < 4; ++s) ar[slot][s] = *(const bf16x8*)(ap + (size_t)(s * 16) * lda + (j) * 32); \
        br[slot][0] = *(const bf16x8*)(wp + (j) * 32); br[slot][1] = *(const bf16x8*)(wp + (size_t)16 * ldw + (j) * 32); } while (0)
#pragma unroll
    for (int j = 0; j < 4; ++j) DG_LOAD(j, j);
#pragma unroll
    for (int j = 0; j < 16; ++j) { const int slot = j & 3;
#pragma unroll
        for (int s = 0; s < 4; ++s) { acc[s][0] = __builtin_amdgcn_mfma_f32_16x16x32_bf16(br[slot][0], ar[slot][s], acc[s][0], 0, 0, 0); acc[s][1] = __builtin_amdgcn_mfma_f32_16x16x32_bf16(br[slot][1], ar[slot][s], acc[s][1], 0, 0, 0); }
        if (j + 4 < 16) DG_LOAD(slot, j + 4); }
#undef DG_LOAD
    LAS f32x4* slab = (LAS f32x4*)lds;
#pragma unroll
    for (int s = 0; s < 4; ++s) { slab[(kq * 16 + (sg * 4 + s) * 2 + 0) * 64 + lane] = acc[s][0]; slab[(kq * 16 + (sg * 4 + s) * 2 + 1) * 64 + lane] = acc[s][1]; }
    __syncthreads();
    f32x4 v[2];
#pragma unroll
    for (int ct = 0; ct < 2; ++ct) { v[ct] = slab[(0 * 16 + wave * 2 + ct) * 64 + lane];
#pragma unroll
        for (int q = 1; q < 4; ++q) v[ct] += slab[(q * 16 + wave * 2 + ct) * 64 + lane]; }
    E(wave * 16 + fr, n0 + fq * 4, fq, v);
    __syncthreads();
}
struct DEpiOut { const float* xs; float* X1; bf16* X1b; float* rsq;
    __device__ __forceinline__ void operator()(int row, int col, int fq, const f32x4 (&v)[2]) const { float ss = 0.f;
#pragma unroll
        for (int ct = 0; ct < 2; ++ct) { const size_t o = (size_t)row * D + col + ct * 16; const f32x4 x = v[ct] + *(const f32x4*)(xs + o); *(f32x4*)(X1 + o) = x; ss += pg8::dot4(x);
            v2u w; w.x = pk2(x[0], x[1]); w.y = pk2(x[2], x[3]); *(v2u*)(X1b + o) = w; }
        ss += __shfl_xor(ss, 16); ss += __shfl_xor(ss, 32);
        if (fq == 0) rsq[row * 64 + (col >> 5)] = ss; }
};
struct DEpiUp { bf16* Fd; const float* rsq;
    __device__ __forceinline__ void operator()(int row, int col, int fq, const f32x4 (&v)[2]) const {
        const float* rp = rsq + row * 64 + fq * 16; float t = 0.f;
#pragma unroll
        for (int i = 0; i < 4; ++i) { const f32x4 p = *(const f32x4*)(rp + 4 * i); t += (p[0] + p[1]) + (p[2] + p[3]); }
        t += __shfl_xor(t, 16); t += __shfl_xor(t, 32);
        const float s = 1.0f / sqrtf(t * (1.0f / D) + EPS);
#pragma unroll
        for (int ct = 0; ct < 2; ++ct) { f32x4 x = v[ct] * s;
#pragma unroll
            for (int j = 0; j < 4; ++j) { const float a = fmaxf(x[j], 0.f); x[j] = a * a; }
            v2u w; w.x = pk2(x[0], x[1]); w.y = pk2(x[2], x[3]); *(v2u*)(Fd + (size_t)row * FF + col + ct * 16) = w; } }
};
struct DEpiDown { float* Pd;
    __device__ __forceinline__ void operator()(int row, int col, int fq, const f32x4 (&v)[2]) const {
#pragma unroll
        for (int ct = 0; ct < 2; ++ct) *(f32x4*)(Pd + (size_t)row * D + col + ct * 16) = v[ct]; }
};

struct Args { const float* in[21]; float* out; unsigned char* ws; int ph_lo, ph_hi; };
enum { I_XP = 0, I_XS, I_SLRU, I_SCONV, I_SPOOL, I_GMIX, I_WIN, I_CONVW, I_CONVB, I_WA, I_BA, I_WX, I_BX, I_LAM, I_WPOOL, I_PSCALE, I_WOUT, I_GMLP, I_WUP, I_WDOWN, I_GFIN };

__device__ __forceinline__ float wave_sum(float v) {
#pragma unroll
    for (int o = 1; o < 64; o <<= 1) v += __shfl_xor(v, o);
    return v;
}
__device__ __forceinline__ void p0_transpose_item(const float* W, int K, int N, bf16* WT, const float* kscale, LAS float* scr, int item, int lane) {
    const int nblk = N / 32, kb = item / nblk, nb = item % nblk, k0 = 64 * kb, n0 = 32 * nb;
#pragma unroll 8
    for (int i = 0; i < 32; ++i) { const int kk = 2 * i + (lane >> 5); float v = W[(size_t)(k0 + kk) * N + n0 + (lane & 31)]; if (kscale) v *= kscale[k0 + kk]; scr[kk * 33 + (lane & 31)] = v; }
    LDS_WAIT(); asm volatile("" ::: "memory");
    const int c = lane & 7;
#pragma unroll
    for (int j = 0; j < 4; ++j) { const int n = (lane >> 3) + 8 * j; const LAS float* s = scr + (8 * c) * 33 + n;
        v4u o; o.x = pk2(s[0 * 33], s[1 * 33]); o.y = pk2(s[2 * 33], s[3 * 33]); o.z = pk2(s[4 * 33], s[5 * 33]); o.w = pk2(s[6 * 33], s[7 * 33]);
        *(v4u*)(WT + (size_t)(n0 + n) * K + k0 + 8 * c) = o; }
    LDS_WAIT(); asm volatile("" ::: "memory");
}

__device__ __forceinline__ void phase0(const Args& a, LAS unsigned char* lds, int G) {
    const int tid = threadIdx.x, lane = tid & 63, wave = __builtin_amdgcn_readfirstlane(tid >> 6);
    unsigned char* ws = a.ws;
    LAS float* scr = (LAS float*)(lds + wave * 16384);
    const int gw = blockIdx.x * NWAVES + wave, NGW = G * NWAVES;
    constexpr int I_IN = (D / 64) * (NIN / 32), I_OUT = (D / 64) * (D / 32), I_UP = (D / 64) * (FF / 32), I_DOWN = (FF / 64) * (D / 32), I_G = 8 * 8, I_P = 4 * 32;
    constexpr int NITEMS = I_IN + I_OUT + I_UP + I_DOWN + 2 * I_G + I_P;
    for (int m = gw; m < MP; m += NGW) {
        bf16* orow = (bf16*)(ws + WS_H) + (size_t)m * D;
        if (m >= MTOT) {
#pragma unroll
            for (int j = 0; j < 4; ++j) *((v4u*)orow + lane + 64 * j) = (v4u){0u, 0u, 0u, 0u};
            continue;
        }
        const float* xrow = (m < TP) ? a.in[I_XP] + (size_t)m * D : a.in[I_XS] + (size_t)(m - TP) * D;
        const f32x4* xr = (const f32x4*)xrow + lane; const f32x4* gr = (const f32x4*)a.in[I_GMIX] + lane;
        f32x4 v[8]; float s = 0.f;
#pragma unroll
        for (int j = 0; j < 8; ++j) { v[j] = xr[64 * j]; s += pg8::dot4(v[j]); }
        const float rstd = 1.0f / sqrtf(wave_sum(s) * (1.0f / D) + EPS);
        v2u* o8 = (v2u*)orow + lane;
#pragma unroll
        for (int j = 0; j < 8; ++j) { const f32x4 g = gr[64 * j]; v2u o; o.x = pk2(v[j][0] * rstd * g[0], v[j][1] * rstd * g[1]); o.y = pk2(v[j][2] * rstd * g[2], v[j][3] * rstd * g[3]); o8[64 * j] = o; }
    }
    for (int it = gw; it < NITEMS; it += NGW) {
        int r = it;
        if (r < I_IN) { p0_transpose_item(a.in[I_WIN], D, NIN, (bf16*)(ws + WS_WIN), nullptr, scr, r, lane); continue; } r -= I_IN;
        if (r < I_OUT) { p0_transpose_item(a.in[I_WOUT], D, D, (bf16*)(ws + WS_WOUT), nullptr, scr, r, lane); continue; } r -= I_OUT;
        if (r < I_UP) { p0_transpose_item(a.in[I_WUP], D, FF, (bf16*)(ws + WS_WUP), a.in[I_GMLP], scr, r, lane); continue; } r -= I_UP;
        if (r < I_DOWN) { p0_transpose_item(a.in[I_WDOWN], FF, D, (bf16*)(ws + WS_WDOWN), nullptr, scr, r, lane); continue; } r -= I_DOWN;
        if (r < I_G) { const int h = r >> 3; p0_transpose_item(a.in[I_WA] + h * 16384, 128, 128, (bf16*)(ws + WS_WA) + h * 16384, nullptr, scr, r & 7, lane); continue; } r -= I_G;
        if (r < I_G) { const int h = r >> 3; p0_transpose_item(a.in[I_WX] + h * 16384, 128, 128, (bf16*)(ws + WS_WX) + h * 16384, nullptr, scr, r & 7, lane); continue; } r -= I_G;
        { const int g = r >> 5; p0_transpose_item(a.in[I_WPOOL] + g * 65536, 256, 256, (bf16*)(ws + WS_WPOOL) + g * 65536, nullptr, scr, r & 31, lane); }
    }
}

constexpr int XCS = 132, XAS = 136, PAS = 264;
__device__ __forceinline__ float softplusf_(float z) { return fmaxf(z, 0.f) + log1pf(__expf(-fabsf(z))); }

__device__ __forceinline__ void lru_unit(const Args& a, LAS unsigned char* lds, bool decode, int b, int ch, int h) {
    const int tid = threadIdx.x, lane = tid & 63, wave = __builtin_amdgcn_readfirstlane(tid >> 6);
    LAS float* XC = (LAS float*)lds; LAS float* AA = (LAS float*)(lds + 33792); LAS bf16* XA = (LAS bf16*)(lds + 67584); LAS float* SG = (LAS float*)(lds + 84992);
    const float* U = (const float*)(a.ws + WS_U);
    const int c = tid & 127, tq = tid >> 7, cg = h * 128 + c, t0 = ch * 64;
    const size_t rowbase = decode ? (size_t)(TP + ch * 64) : (size_t)b * SEQ + t0;
    {
        const float* cw = a.in[I_CONVW]; const float w0 = cw[cg], w1 = cw[WL + cg], w2 = cw[2 * WL + cg], w3 = cw[3 * WL + cg], cb = a.in[I_CONVB][cg];
        const int ts = tq * 16;
        if (!decode) {
            float xm3 = (t0 + ts - 3 >= 0) ? U[(rowbase + ts - 3) * NIN + cg] : 0.f, xm2 = (t0 + ts - 2 >= 0) ? U[(rowbase + ts - 2) * NIN + cg] : 0.f, xm1 = (t0 + ts - 1 >= 0) ? U[(rowbase + ts - 1) * NIN + cg] : 0.f;
#pragma unroll 4
            for (int s = 0; s < 16; ++s) { const int t = ts + s; const float x0 = U[(rowbase + t) * NIN + cg];
                const float xc = cb + w0 * xm3 + w1 * xm2 + w2 * xm1 + w3 * x0; XC[t * XCS + c] = xc; XA[t * XAS + c] = f2bf(xc); xm3 = xm2; xm2 = xm1; xm1 = x0; }
            if (ch == SEQ / 64 - 1 && tq == 3) { float* cp = a.out + O_CP + (size_t)b * 3 * WL + cg; cp[0] = xm3; cp[WL] = xm2; cp[2 * WL] = xm1; }
        } else {
            const float* sc = a.in[I_SCONV]; float* cs = a.out + O_CS;
#pragma unroll 4
            for (int s = 0; s < 16; ++s) { const int t = ts + s; const int bi = ch * 64 + t;
                const float s0 = sc[((size_t)bi * 3 + 0) * WL + cg], s1 = sc[((size_t)bi * 3 + 1) * WL + cg], s2 = sc[((size_t)bi * 3 + 2) * WL + cg], x0 = U[(rowbase + t) * NIN + cg];
                const float xc = cb + w0 * s0 + w1 * s1 + w2 * s2 + w3 * x0; XC[t * XCS + c] = xc; XA[t * XAS + c] = f2bf(xc);
                cs[((size_t)bi * 3 + 0) * WL + cg] = s1; cs[((size_t)bi * 3 + 1) * WL + cg] = s2; cs[((size_t)bi * 3 + 2) * WL + cg] = x0; }
        }
    }
    __syncthreads();
    {
        const int rs = wave & 3, chf = wave >> 2, fr = lane & 15, fq = lane >> 4;
        bf16x8 af[4];
#pragma unroll
        for (int kk = 0; kk < 4; ++kk) af[kk] = *(const LAS bf16x8*)(XA + (rs * 16 + fr) * XAS + kk * 32 + fq * 8);
        f32x4 acca[4], accx[4];
#pragma unroll
        for (int ct = 0; ct < 4; ++ct) { acca[ct] = (f32x4){0.f, 0.f, 0.f, 0.f}; accx[ct] = (f32x4){0.f, 0.f, 0.f, 0.f}; }
        const bf16* WaT = (const bf16*)(a.ws + WS_WA) + (size_t)h * 16384; const bf16* WxT = (const bf16*)(a.ws + WS_WX) + (size_t)h * 16384;
#pragma unroll
        for (int ct = 0; ct < 4; ++ct) { const int n = chf * 64 + ct * 16 + fr;
#pragma unroll
            for (int kk = 0; kk < 4; ++kk) { const bf16x8 ba = *(const bf16x8*)(WaT + n * 128 + kk * 32 + fq * 8), bx = *(const bf16x8*)(WxT + n * 128 + kk * 32 + fq * 8);
                acca[ct] = __builtin_amdgcn_mfma_f32_16x16x32_bf16(af[kk], ba, acca[ct], 0, 0, 0); accx[ct] = __builtin_amdgcn_mfma_f32_16x16x32_bf16(af[kk], bx, accx[ct], 0, 0, 0); } }
#pragma unroll
        for (int ct = 0; ct < 4; ++ct) { const int cl = chf * 64 + ct * 16 + fr, cgg = h * 128 + cl;
            const float ba_ = a.in[I_BA][cgg], bx_ = a.in[I_BX][cgg], sp = softplusf_(-a.in[I_LAM][cgg]);
#pragma unroll
            for (int reg = 0; reg < 4; ++reg) { const int t = rs * 16 + fq * 4 + reg;
                const float r = sigmoidf_(acca[ct][reg] + ba_), ig = sigmoidf_(accx[ct][reg] + bx_);
                const float la = -8.0f * r * sp, av = __expf(la);
                const float mult = (!decode && t0 + t == 0) ? 1.0f : sqrtf(-expm1f(2.0f * la));
                const float xc = XC[t * XCS + cl]; XC[t * XCS + cl] = xc * ig * mult; AA[t * XCS + cl] = av; } }
    }
    __syncthreads();
    if (!decode) {
        float hh = 0.f, pp = 1.f;
#pragma unroll 4
        for (int s = 0; s < 16; ++s) { const int t = tq * 16 + s; const float av = AA[t * XCS + c], bv = XC[t * XCS + c]; hh = av * hh + bv; pp *= av; XC[t * XCS + c] = hh; AA[t * XCS + c] = pp; }
        SG[(tq * 128 + c) * 2] = pp; SG[(tq * 128 + c) * 2 + 1] = hh;
        __syncthreads();
        float Ain = 1.f, Bin = 0.f;
        for (int s2 = 0; s2 < tq; ++s2) { const float P = SG[(s2 * 128 + c) * 2], H = SG[(s2 * 128 + c) * 2 + 1]; Bin = P * Bin + H; Ain *= P; }
        float* Acum = a.out + O_ACUM; float* Bcum = a.out + O_BCUM; float ac = 0.f, bc = 0.f;
#pragma unroll 4
        for (int s = 0; s < 16; ++s) { const int t = tq * 16 + s; const float p = AA[t * XCS + c], hl = XC[t * XCS + c]; ac = p * Ain; bc = p * Bin + hl;
            Acum[(rowbase + t) * WL + cg] = ac; Bcum[(rowbase + t) * WL + cg] = bc; }
        if (tq == 3) { ((float*)(a.ws + WS_AGGA))[((size_t)b * 32 + ch) * WL + cg] = ac; ((float*)(a.ws + WS_AGGB))[((size_t)b * 32 + ch) * WL + cg] = bc; }
    } else {
        const float* h0 = a.in[I_SLRU]; float* hs = a.out + O_HS; bf16* Y = (bf16*)(a.ws + WS_H);
#pragma unroll 4
        for (int s = 0; s < 16; ++s) { const int t = tq * 16 + s; const int bi = ch * 64 + t;
            const float hn = AA[t * XCS + c] * h0[(size_t)bi * WL + cg] + XC[t * XCS + c]; hs[(size_t)bi * WL + cg] = hn;
            const float gate = U[(rowbase + t) * NIN + WL + cg]; Y[(rowbase + t) * D + cg] = f2bf(hn * gelu_tanh(gate)); }
    }
    __syncthreads();
}

__device__ __forceinline__ void pool_unit(const Args& a, LAS unsigned char* lds, bool decode, int b, int ch, int g) {
    const int tid = threadIdx.x, lane = tid & 63, wave = __builtin_amdgcn_readfirstlane(tid >> 6);
    LAS float* PU = (LAS float*)lds; LAS bf16* PA = (LAS bf16*)(lds + 80896);
    const float* U = (const float*)(a.ws + WS_U);
    const int c = tid & 255, half = tid >> 8, cgp = g * 256 + c, t0 = ch * 64, w = 2 << g;
    const size_t rowbase = decode ? (size_t)(TP + ch * 64) : (size_t)b * SEQ + t0;
    if (!decode) {
        for (int j = half; j < 79; j += 2) { const int t = j - 15; PU[j * 256 + c] = (t0 + t >= 0) ? U[(rowbase + t) * NIN + 2 * WL + cgp] : 0.f; }
        __syncthreads();
        if (ch == SEQ / 64 - 1) { float* pp = a.out + O_PP + (size_t)b * 15 * WL + cgp; for (int k = half; k < 15; k += 2) pp[(size_t)k * WL] = PU[(64 + k) * 256 + c]; }
        const int ts = half * 32; float S = 0.f;
        for (int i = 0; i < w; ++i) S += PU[(ts + 15 - i) * 256 + c];
        const float invw = 1.0f / (float)w;
#pragma unroll 4
        for (int s = 0; s < 32; ++s) { const int t = ts + s; const int pos = t0 + t; const float cur = PU[(t + 15) * 256 + c];
            const float inv = (pos + 1 >= w) ? invw : 1.0f / (float)(pos + 1);
            PA[t * PAS + c] = f2bf(S * inv - cur);
            if (s < 31) S += PU[(t + 16) * 256 + c] - PU[(t + 16 - w) * 256 + c]; }
    } else {
        const float* sp = a.in[I_SPOOL]; float* ps = a.out + O_PS; const float invw = 1.0f / (float)w;
        for (int s = 0; s < 32; ++s) { const int t = half * 32 + s; const int bi = ch * 64 + t; const float cur = U[(rowbase + t) * NIN + 2 * WL + cgp];
            float S = cur;
#pragma unroll
            for (int k = 0; k < 15; ++k) { const float v = sp[((size_t)bi * 15 + k) * WL + cgp]; if (k >= 16 - w) S += v; if (k >= 1) ps[((size_t)bi * 15 + k - 1) * WL + cgp] = v; }
            ps[((size_t)bi * 15 + 14) * WL + cgp] = cur;
            PA[t * PAS + c] = f2bf(S * invw - cur); }
    }
    __syncthreads();
    {
        const int rs = wave & 3, nh = wave >> 2, fr = lane & 15, fq = lane >> 4;
        bf16x8 af[8];
#pragma unroll
        for (int kk = 0; kk < 8; ++kk) af[kk] = *(const LAS bf16x8*)(PA + (rs * 16 + fr) * PAS + kk * 32 + fq * 8);
        const bf16* WT = (const bf16*)(a.ws + WS_WPOOL) + (size_t)g * 65536; bf16* Y = (bf16*)(a.ws + WS_H); const float* psc = a.in[I_PSCALE];
#pragma unroll 2
        for (int ct = 0; ct < 8; ++ct) { const int n = nh * 128 + ct * 16 + fr; f32x4 acc = (f32x4){0.f, 0.f, 0.f, 0.f};
#pragma unroll
            for (int kk = 0; kk < 8; ++kk) { const bf16x8 wf = *(const bf16x8*)(WT + n * 256 + kk * 32 + fq * 8); acc = __builtin_amdgcn_mfma_f32_16x16x32_bf16(wf, af[kk], acc, 0, 0, 0); }
            const int n4 = nh * 128 + ct * 16 + fq * 4; const f32x4 sc = *(const f32x4*)(psc + g * 256 + n4);
            v2u o; o.x = pk2(acc[0] * sc[0], acc[1] * sc[1]); o.y = pk2(acc[2] * sc[2], acc[3] * sc[3]);
            *(v2u*)(Y + (rowbase + rs * 16 + fr) * D + WL + g * 256 + n4) = o; }
    }
    __syncthreads();
}

__device__ __forceinline__ void phase2(const Args& a, LAS unsigned char* lds, int G) {
    constexpr int N_LP = NB * 32 * 8, N_PP = NB * 32 * 4, N_LD = 2 * 8, N_PD = 2 * 4, NU = N_LP + N_PP + N_LD + N_PD;
    for (int it = blockIdx.x; it < NU; it += G) {
        int r = it;
        if (r < N_PP) { const int g = r & 3, ch = (r >> 2) & 31, b = r >> 7; pool_unit(a, lds, false, b, ch, g); continue; } r -= N_PP;
        if (r < N_LP) { const int h = r & 7, ch = (r >> 3) & 31, b = r >> 8; lru_unit(a, lds, false, b, ch, h); continue; } r -= N_LP;
        if (r < N_LD) { lru_unit(a, lds, true, 0, r >> 3, r & 7); continue; } r -= N_LD;
        pool_unit(a, lds, true, 0, r >> 2, r & 3);
    }
}

__device__ __forceinline__ void phase2b(const Args& a, LAS unsigned char* lds, int G) {
    const int tid = threadIdx.x; const float* U = (const float*)(a.ws + WS_U); bf16* Y = (bf16*)(a.ws + WS_H);
    const float* Acum = a.out + O_ACUM; const float* Bcum = a.out + O_BCUM; const float* AggA = (const float*)(a.ws + WS_AGGA); const float* AggB = (const float*)(a.ws + WS_AGGB);
    for (int j = blockIdx.x; j < D / 32; j += G) {
        DEpiOut E{a.in[I_XS], a.out + O_Y + (size_t)TP * D, (bf16*)(a.ws + WS_X1B) + (size_t)TP * D, (float*)(a.ws + WS_RSQD1)};
        dec_gemm_unit(lds, (const bf16*)(a.ws + WS_H) + (size_t)TP * D, D, (const bf16*)(a.ws + WS_WOUT), D, 32 * j, E); }
    for (int it = blockIdx.x; it < NB * 32 * 2; it += G) {
        const int rh = it & 1, ch = (it >> 1) & 31, b = it >> 6, c2 = tid * 2;
        f32x2 carry = (f32x2){0.f, 0.f};
#pragma unroll
        for (int k = 0; k < 31; ++k) { const f32x2 A = *(const f32x2*)(AggA + ((size_t)b * 32 + k) * WL + c2), B = *(const f32x2*)(AggB + ((size_t)b * 32 + k) * WL + c2); const f32x2 nc = A * carry + B; carry = (k < ch) ? nc : carry; }
        const size_t row0 = (size_t)b * SEQ + ch * 64 + rh * 32; f32x2 hlast = (f32x2){0.f, 0.f};
#pragma unroll 4
        for (int r = 0; r < 32; ++r) { const size_t row = row0 + r;
            const f32x2 A = *(const f32x2*)(Acum + row * WL + c2), B = *(const f32x2*)(Bcum + row * WL + c2), gt = *(const f32x2*)(U + row * NIN + WL + c2);
            const f32x2 hv = A * carry + B; hlast = hv;
            *(unsigned*)(Y + row * D + c2) = pk2(hv.x * gelu_tanh(gt.x), hv.y * gelu_tanh(gt.y)); }
        if (ch == 31 && rh == 1) *(f32x2*)(a.out + O_HP + (size_t)b * WL + c2) = hlast;
    }
}

__device__ __forceinline__ void phase6(const Args& a, int G) {
    const int tid = threadIdx.x, lane = tid & 63, wave = tid >> 6; const float* rsq = (const float*)(a.ws + WS_RSQ2);
    const f32x4* gr = (const f32x4*)a.in[I_GFIN] + lane;
    for (int m = blockIdx.x * NWAVES + wave; m < MTOT; m += G * NWAVES) {
        f32x4* xr = (f32x4*)(a.out + O_Y + (size_t)m * D) + lane;
        if (m < TP) {
            const float rstd = 1.0f / sqrtf(wave_sum(lane < 32 ? rsq[(size_t)m * 32 + lane] : 0.f) * (1.0f / D) + EPS);
#pragma unroll
            for (int j = 0; j < 8; ++j) { const f32x4 g = gr[64 * j]; xr[64 * j] = xr[64 * j] * rstd * g; }
        } else {
            const f32x4* pd = (const f32x4*)(a.ws + WS_PD) + (size_t)(m - TP) * (D / 4) + lane; f32x4 v[8]; float s = 0.f;
#pragma unroll
            for (int j = 0; j < 8; ++j) { v[j] = xr[64 * j];
#pragma unroll
                for (int q = 0; q < 4; ++q) v[j] += pd[(size_t)q * TS * (D / 4) + 64 * j];
                s += pg8::dot4(v[j]); }
            const float rstd = 1.0f / sqrtf(wave_sum(s) * (1.0f / D) + EPS);
#pragma unroll
            for (int j = 0; j < 8; ++j) { const f32x4 g = gr[64 * j]; xr[64 * j] = v[j] * rstd * g; }
        }
    }
}

__global__ void __launch_bounds__(NWAVES * 64, 2) hymba_fwd(Args args) {
    extern __shared__ __attribute__((aligned(16))) unsigned char lds_raw[];
    LAS unsigned char* lds = (LAS unsigned char*)lds_raw;
    const int tid = threadIdx.x, G = gridDim.x;
    unsigned char* ws = args.ws;
    unsigned* ctl = (unsigned*)(ws + WS_CTL);
    for (int u = tid; u < (LDS_BYTES - LDSCTL_OFF) / 4; u += NWAVES * 64) ((LAS unsigned*)(lds + LDSCTL_OFF))[u] = 0u;
    __syncthreads();
    XcdBarrier bar; bar.bar = ctl + CW_BAR; bar.x = 0; bar.st = nullptr;
    if (MK_N_LAUNCHES == 1) bar = xcd_barrier_post(ctl + CW_BAR, (volatile LAS unsigned*)(lds + LDSCTL_OFF + 64));
    const int lo = args.ph_lo, hi = args.ph_hi;
#define IN(k) (lo <= (k) && (k) < hi)
#define SEAM(k) do { if (IN(k) && IN((k) + 1)) xcd_barrier(bar); } while (0)
    float* rsq1 = (float*)(ws + WS_RSQ1); float* rsq2 = (float*)(ws + WS_RSQ2);
    if (IN(0)) { phase0(args, lds, G); } SEAM(0);
    if (IN(1)) {
        pg8::Gemm g{(const pg8::bf16_t*)(ws + WS_H), (const pg8::bf16_t*)(ws + WS_WIN), MP, NIN, D}; pg8::StaticOrder S; S.init(MP, NIN, G, (int)blockIdx.x);
        pg8::EpiU E{(float*)(ws + WS_U), NIN};
        pg8::gemm_phase<pg8::EpiU, pg8::StaticOrder, true, true>(lds, g, S, E);
    } SEAM(1);
    if (IN(2)) { phase2(args, lds, G); } SEAM(2);
    if (IN(3)) { phase2b(args, lds, G); } SEAM(3);
    if (IN(4)) {
        for (int j = blockIdx.x; j < FF / 32; j += G) {
            DEpiUp E{(bf16*)(ws + WS_FD), (const float*)(ws + WS_RSQD1)};
            dec_gemm_unit(lds, (const bf16*)(ws + WS_X1B) + (size_t)TP * D, D, (const bf16*)(ws + WS_WUP), D, 32 * j, E); }
        pg8::Gemm g{(const pg8::bf16_t*)(ws + WS_H), (const pg8::bf16_t*)(ws + WS_WOUT), TP, D, D}; pg8::StaticOrder S; S.init(TP, D, G, (int)blockIdx.x);
        pg8::EpiOut E{args.in[I_XP], args.out + O_Y, (pg8::bf16_t*)(ws + WS_X1B), rsq1};
        pg8::gemm_phase<pg8::EpiOut, pg8::StaticOrder, true, true>(lds, g, S, E);
    } SEAM(4);
    if (IN(5)) {
        for (int j = blockIdx.x; j < 4 * (D / 32); j += G) {
            const int ks = j >> 6, nt = j & 63; DEpiDown E{(float*)(ws + WS_PD) + (size_t)ks * TS * D};
            dec_gemm_unit(lds, (const bf16*)(ws + WS_FD) + ks * 2048, FF, (const bf16*)(ws + WS_WDOWN) + ks * 2048, FF, 32 * nt, E); }
        pg8::Gemm g{(const pg8::bf16_t*)(ws + WS_X1B), (const pg8::bf16_t*)(ws + WS_WUP), TP, FF, D}; pg8::StaticOrder S; S.init(TP, FF, G, (int)blockIdx.x);
        pg8::EpiUp E{(pg8::bf16_t*)(ws + WS_F), rsq1};
        pg8::gemm_phase<pg8::EpiUp, pg8::StaticOrder, true, true>(lds, g, S, E);
    } SEAM(5);
    if (IN(6)) {
        pg8::Gemm g{(const pg8::bf16_t*)(ws + WS_F), (const pg8::bf16_t*)(ws + WS_WDOWN), TP, D, FF}; pg8::StaticOrder S; S.init(TP, D, G, (int)blockIdx.x);
        pg8::EpiDown E{args.out + O_Y, rsq2};
        pg8::gemm_phase<pg8::EpiDown, pg8::StaticOrder, true, true>(lds, g, S, E);
    } SEAM(6);
    if (IN(7)) { phase6(args, G); }
#undef IN
#undef SEAM
}

extern "C" void kernel_launch(void* const* d_in, const int* in_sizes, int n_in, void* d_out, int out_size, void* d_ws, size_t ws_size, hipStream_t stream) {
    static int grid = 0;
    if (grid == 0) {
        if (n_in != 21 || (size_t)out_size != O_END || ws_size < WS_END) { fprintf(stderr, "kernel_launch: unexpected shapes: n_in %d out %d ws %zu\n", n_in, out_size, ws_size); grid = -1; return; }
        int dev = 0, cus = 0, per_cu = 0;
        if (hipGetDevice(&dev) != hipSuccess || hipDeviceGetAttribute(&cus, hipDeviceAttributeMultiprocessorCount, dev) != hipSuccess) { grid = -1; return; }
        if (hipFuncSetAttribute((const void*)hymba_fwd, hipFuncAttributeMaxDynamicSharedMemorySize, LDS_BYTES) != hipSuccess) { fprintf(stderr, "kernel_launch: hipFuncSetAttribute failed\n"); grid = -1; return; }
        if (hipOccupancyMaxActiveBlocksPerMultiprocessor(&per_cu, (const void*)hymba_fwd, NWAVES * 64, LDS_BYTES) != hipSuccess || per_cu < 1) { fprintf(stderr, "kernel_launch: occupancy query says %d\n", per_cu); per_cu = 1; }
        (void)hipGetLastError();
        grid = cus;
    }
    if (grid < 0) return;
    (void)hipMemsetAsync((char*)d_ws + WS_CTL, 0, CTL_ZERO_BYTES, stream);
    Args a{};
    for (int i = 0; i < 21; ++i) a.in[i] = (const float*)d_in[i];
    a.out = (float*)d_out; a.ws = (unsigned char*)d_ws;
#if MK_N_LAUNCHES == 1
    a.ph_lo = 0; a.ph_hi = NPHASE;
    void* kargs[] = {&a};
    hipError_t e = hipLaunchCooperativeKernel((const void*)hymba_fwd, dim3(grid), dim3(NWAVES * 64), kargs, LDS_BYTES, stream);
    if (e != hipSuccess) fprintf(stderr, "kernel_launch: cooperative launch failed: %s (grid %d)\n", hipGetErrorString(e), grid);
#else
    for (int p = 0; p < NPHASE; ++p) { a.ph_lo = p; a.ph_hi = p + 1; hipLaunchKernelGGL(hymba_fwd, dim3(grid), dim3(NWAVES * 64), LDS_BYTES, stream, a); }
#endif
}
```

```cpp
#include <hip/hip_runtime.h>
#include <cstdio>
#include <cstdint>
namespace pg8 {
#define PG8_LAS __attribute__((address_space(3)))
typedef unsigned short bf16_t;
typedef short bf16x8 __attribute__((ext_vector_type(8)));
typedef float f32x4 __attribute__((ext_vector_type(4)));
typedef unsigned u32x4 __attribute__((ext_vector_type(4)));
constexpr int BM = 256, BK = 64, HALF = 128, HTB = HALF * BK * 2  , STAGE_BYTES = 8 * HTB, NXCD = 8, WGM = 8;

__host__ __device__ __forceinline__ int lds_byte(int r, int c) { const int st = (r >> 4) * 2 + (c >> 5), rr = r & 15, cc = c & 31, ob = rr * 64 + cc * 2; return st * 1024 + (ob ^ (((ob >> 9) & 1) << 5)); }
__host__ __device__ __forceinline__ void stage_rc(int b, int& R, int& C) { const int st = b / 1024, sb = b % 1024, swz = sb ^ (((sb >> 9) & 1) << 5); R = (st >> 1) * 16 + swz / 64; C = (st & 1) * 32 + (swz % 64) / 2; }
__host__ __device__ __forceinline__ int perm32(int rho) { const int n = rho >> 4, i = rho & 15; return 8 * (i >> 2) + 4 * n + (i & 3); }

struct Unit { int pm, pn; };
struct Gemm { const bf16_t* A; const bf16_t* Bt; int M, N, K; };

struct StaticOrder {
    int nM, nN, nwg, G, c;
    __host__ __device__ void init(int M, int N, int G_, int c_) { nM = M / BM; nN = N / BM; nwg = nM * nN; G = G_; c = c_; }
    __host__ __device__ bool next(int i, Unit& u) const {
        const long L = (long)i * G + c; if (L >= nwg) return false;
        int wgid = (int)L; { const int q = nwg / NXCD, r = nwg % NXCD, xcd = wgid % NXCD, off = wgid / NXCD; wgid = (xcd < r ? xcd * (q + 1) : r * (q + 1) + (xcd - r) * q) + off; }
        const int nig = WGM * nN, gid = wgid / nig, fm = gid * WGM, gsz = (nM - fm) < WGM ? (nM - fm) : WGM;
        u.pm = fm + ((wgid % nig) % gsz); u.pn = (wgid % nig) / gsz; return true;
    }
    __device__ __forceinline__ void a_ready(const Unit&) const {}
    __device__ __forceinline__ void done(const Unit&) const {}
};

__device__ __forceinline__ unsigned cvt_pk_bf16(float lo, float hi) { unsigned r; asm volatile("v_cvt_pk_bf16_f32 %0, %1, %2" : "=v"(r) : "v"(lo), "v"(hi)); return r; }
typedef float f32x2 __attribute__((ext_vector_type(2)));
constexpr int E_D = 2048, E_TP = 8192, E_M = 8320, E_FF = 8192;
constexpr float E_EPS = 1e-6f;
__device__ __forceinline__ float dot4(const f32x4 v) { return (v[0] * v[0] + v[1] * v[1]) + (v[2] * v[2] + v[3] * v[3]); }

struct EpiU {
    static constexpr bool PERM = false, AFTER_DRAIN = false;
    float* C; int ldc;
    __device__ __forceinline__ void operator()(const f32x4 (&acc)[2][2][4][2], const Unit& u, int wr, int wc, int fr, int fq) const {
        const int row0 = u.pm * BM + wr * 64 + fr, col0 = u.pn * BM + wc * 32 + 4 * fq;
#pragma unroll
        for (int ai = 0; ai < 2; ++ai)
#pragma unroll
            for (int m = 0; m < 4; ++m) { const int row = row0 + ai * HALF + m * 16;
                if (row < E_M) { float* rowp = C + (size_t)row * ldc + col0;
#pragma unroll
                    for (int bj = 0; bj < 2; ++bj)
#pragma unroll
                        for (int n = 0; n < 2; ++n) *(f32x4*)(rowp + bj * HALF + n * 16) = acc[ai][bj][m][n]; } }
    }
};
struct EpiOut {
    static constexpr bool PERM = true, AFTER_DRAIN = false;
    const float* xp; float* X1; bf16_t* X1b; float* rowsq;
    __device__ __forceinline__ void operator()(const f32x4 (&acc)[2][2][4][2], const Unit& u, int wr, int wc, int fr, int fq) const {
        const int row0 = u.pm * BM + wr * 64 + fr, col0 = u.pn * BM + wc * 32 + 8 * fq;
#pragma unroll
        for (int ai = 0; ai < 2; ++ai)
#pragma unroll
            for (int m = 0; m < 4; ++m) { const int row = row0 + ai * HALF + m * 16;
                {
                    const float* xr = xp + (size_t)row * E_D + col0;
                    float* o1 = X1 + (size_t)row * E_D + col0; bf16_t* ob = X1b + (size_t)row * E_D + col0; float ss = 0.f;
#pragma unroll
                    for (int bj = 0; bj < 2; ++bj) {
                        const f32x4 v0 = acc[ai][bj][m][0] + *(const f32x4*)(xr + bj * HALF), v1 = acc[ai][bj][m][1] + *(const f32x4*)(xr + bj * HALF + 4);
                        *(f32x4*)(o1 + bj * HALF) = v0; *(f32x4*)(o1 + bj * HALF + 4) = v1; ss += dot4(v0) + dot4(v1);
                        u32x4 w; w.x = cvt_pk_bf16(v0[0], v0[1]); w.y = cvt_pk_bf16(v0[2], v0[3]); w.z = cvt_pk_bf16(v1[0], v1[1]); w.w = cvt_pk_bf16(v1[2], v1[3]);
                        *(u32x4*)(ob + bj * HALF) = w; }
                    ss += __shfl_xor(ss, 16); ss += __shfl_xor(ss, 32);
                    if (fq == 0) rowsq[(size_t)row * 32 + u.pn * 4 + wc] = ss; } }
    }
};
struct EpiUp {
    static constexpr bool PERM = true, AFTER_DRAIN = false;
    bf16_t* F; const float* rowsq;
    __device__ __forceinline__ void operator()(const f32x4 (&acc)[2][2][4][2], const Unit& u, int wr, int wc, int fr, int fq) const {
        const int row0 = u.pm * BM + wr * 64 + fr, col0 = u.pn * BM + wc * 32 + 8 * fq;
#pragma unroll
        for (int ai = 0; ai < 2; ++ai)
#pragma unroll
            for (int m = 0; m < 4; ++m) { const int row = row0 + ai * HALF + m * 16;
                float s = 0.f;
                { const float* rp = rowsq + (size_t)row * 32 + fq * 8; const f32x4 p0 = *(const f32x4*)rp, p1 = *(const f32x4*)(rp + 4);
                    float t = ((p0[0] + p0[1]) + (p0[2] + p0[3])) + ((p1[0] + p1[1]) + (p1[2] + p1[3])); t += __shfl_xor(t, 16); t += __shfl_xor(t, 32);
                    s = 1.0f / sqrtf(t * (1.0f / E_D) + E_EPS); }
                bf16_t* ob = F + (size_t)row * E_FF + col0;
#pragma unroll
                for (int bj = 0; bj < 2; ++bj) {
                    f32x4 v0 = acc[ai][bj][m][0] * s, v1 = acc[ai][bj][m][1] * s;
#pragma unroll
                    for (int j = 0; j < 4; ++j) { const float a = fmaxf(v0[j], 0.f), b = fmaxf(v1[j], 0.f); v0[j] = a * a; v1[j] = b * b; }
                    u32x4 w; w.x = cvt_pk_bf16(v0[0], v0[1]); w.y = cvt_pk_bf16(v0[2], v0[3]); w.z = cvt_pk_bf16(v1[0], v1[1]); w.w = cvt_pk_bf16(v1[2], v1[3]);
                    *(u32x4*)(ob + bj * HALF) = w; } }
    }
};
struct EpiDown {
    static constexpr bool PERM = false, AFTER_DRAIN = false;
    float* X; float* rowsq;
    __device__ __forceinline__ void operator()(const f32x4 (&acc)[2][2][4][2], const Unit& u, int wr, int wc, int fr, int fq) const {
        const int row0 = u.pm * BM + wr * 64 + fr, col0 = u.pn * BM + wc * 32 + 4 * fq;
#pragma unroll
        for (int ai = 0; ai < 2; ++ai)
#pragma unroll
            for (int m = 0; m < 4; ++m) { const int row = row0 + ai * HALF + m * 16;
                { float* rowp = X + (size_t)row * E_D + col0; float ss = 0.f;
#pragma unroll
                    for (int bj = 0; bj < 2; ++bj)
#pragma unroll
                        for (int n = 0; n < 2; ++n) { const f32x4 v = acc[ai][bj][m][n] + *(const f32x4*)(rowp + bj * HALF + n * 16); *(f32x4*)(rowp + bj * HALF + n * 16) = v; ss += dot4(v); }
                    ss += __shfl_xor(ss, 16); ss += __shfl_xor(ss, 32);
                    if (fq == 0) rowsq[(size_t)row * 32 + u.pn * 4 + wc] = ss; } }
    }
};

struct EpiBf16Plain {
    static constexpr bool PERM = true, AFTER_DRAIN = false;
    bf16_t* O;
    __device__ __forceinline__ void operator()(const f32x4 (&acc)[2][2][4][2], const Unit& u, int wr, int wc, int fr, int fq) const {
        const int row0 = u.pm * BM + wr * 64 + fr, col0 = u.pn * BM + wc * 32 + 8 * fq;
#pragma unroll
        for (int ai = 0; ai < 2; ++ai)
#pragma unroll
            for (int m = 0; m < 4; ++m) { bf16_t* ob = O + (size_t)(row0 + ai * HALF + m * 16) * E_D + col0;
#pragma unroll
                for (int bj = 0; bj < 2; ++bj) { const f32x4 v0 = acc[ai][bj][m][0], v1 = acc[ai][bj][m][1];
                    u32x4 w; w.x = cvt_pk_bf16(v0[0], v0[1]); w.y = cvt_pk_bf16(v0[2], v0[3]); w.z = cvt_pk_bf16(v1[0], v1[1]); w.w = cvt_pk_bf16(v1[2], v1[3]);
                    *(u32x4*)(ob + bj * HALF) = w; } }
    }
};

template <class Epi, class Sched, bool ALIGN_EPI = false, bool SP2 = false>
__device__ __forceinline__ void gemm_phase(PG8_LAS unsigned char* lds, const Gemm g, const Sched& S, const Epi& E) {
    const int tid = threadIdx.x, wid = __builtin_amdgcn_readfirstlane(tid >> 6), lane = tid & 63, wr = wid >> 2, wc = wid & 3, fr = lane & 15, fq = lane >> 4;
    const int K = g.K, nt = K / BK;
    unsigned voffA[2], voffB[2];
#pragma unroll
    for (int i = 0; i < 2; ++i) { int R, C; stage_rc(tid * 16 + i * 8192, R, C); const int Rb = Epi::PERM ? ((R & ~31) + perm32(R & 31)) : R;
        voffA[i] = (unsigned)(R * K + C) * 2u; voffB[i] = (unsigned)(Rb * K + C) * 2u; }
    const size_t kstep = (size_t)(BK * 2);
    const size_t hstep = (size_t)HALF * K * 2;
    const size_t tstep = 2 * hstep;
    const unsigned ldsw = (unsigned)wid * 1024u;
    const int aoff = lds_byte(wr * 64 + fr, fq * 8), boff = lds_byte(wc * 32 + fr, fq * 8);
#define PG8_SA(b, h) (((b) * 2 + (h)) * HTB)
#define PG8_SB(b, h) ((4 + (b) * 2 + (h)) * HTB)
#define PG8_STAGE(bufoff, gbase, voff) do { _Pragma("unroll") for (int _i = 0; _i < 2; ++_i) \
        __builtin_amdgcn_global_load_lds((const unsigned*)((const char*)(gbase) + (voff)[_i]), (PG8_LAS unsigned*)(lds + (bufoff) + ldsw + _i * 8192), 16, 0, 0); } while (0)
#define PG8_LDA(dst, b, h) do { _Pragma("unroll") for (int m = 0; m < 4; ++m) _Pragma("unroll") for (int k = 0; k < 2; ++k) dst[m][k] = *(const PG8_LAS bf16x8*)(lds + PG8_SA(b, h) + aoff + m * 2048 + k * 1024); } while (0)
#define PG8_LDB(dst, b, h) do { _Pragma("unroll") for (int n = 0; n < 2; ++n) _Pragma("unroll") for (int k = 0; k < 2; ++k) dst[n][k] = *(const PG8_LAS bf16x8*)(lds + PG8_SB(b, h) + boff + n * 2048 + k * 1024); } while (0)
#define PG8_MMA(ai, bj, At, Bt) do { __builtin_amdgcn_s_setprio(1); _Pragma("unroll") for (int m = 0; m < 4; ++m) _Pragma("unroll") for (int n = 0; n < 2; ++n) _Pragma("unroll") for (int k = 0; k < 2; ++k) \
        acc[ai][bj][m][n] = __builtin_amdgcn_mfma_f32_16x16x32_bf16(Bt[n][k], At[m][k], acc[ai][bj][m][n], 0, 0, 0); __builtin_amdgcn_s_setprio(0); } while (0)
#define PG8_WAIT_V(n) asm volatile("s_waitcnt vmcnt(" #n ")" ::: "memory")
#define PG8_WAIT_L(n) asm volatile("s_waitcnt lgkmcnt(" #n ")" ::: "memory")
#define PG8_BAR __builtin_amdgcn_s_barrier()
#define PG8_SCHED __builtin_amdgcn_sched_barrier(0)
    Unit cur, nxt; int ui = 0;
    if (!S.next(0, cur)) return;
    f32x4 acc[2][2][4][2];
#pragma unroll
    for (int a = 0; a < 2; ++a)
#pragma unroll
        for (int b = 0; b < 2; ++b)
#pragma unroll
            for (int m = 0; m < 4; ++m)
#pragma unroll
                for (int n = 0; n < 2; ++n) acc[a][b][m][n] = (f32x4){0.f, 0.f, 0.f, 0.f};
    bf16x8 At[4][2], B0[2][2], B1[2][2];
    const char* cA = (const char*)g.A + (size_t)cur.pm * tstep; const char* cB = (const char*)g.Bt + (size_t)cur.pn * tstep;
    S.a_ready(cur);
    if constexpr (SP2) {
        PG8_STAGE(PG8_SB(0, 0), cB, voffB); PG8_STAGE(PG8_SB(0, 1), cB + hstep, voffB); PG8_STAGE(PG8_SA(0, 0), cA, voffA); PG8_STAGE(PG8_SA(0, 1), cA + hstep, voffA);
        if (wr == 1) PG8_BAR;
        PG8_WAIT_V(2); PG8_BAR;
        PG8_STAGE(PG8_SB(1, 0), cB + kstep, voffB); PG8_STAGE(PG8_SA(1, 0), cA + kstep, voffA); PG8_STAGE(PG8_SB(1, 1), cB + hstep + kstep, voffB);
        PG8_WAIT_V(6); PG8_BAR;
    } else {
        PG8_STAGE(PG8_SB(0, 0), cB, voffB); PG8_STAGE(PG8_SA(0, 0), cA, voffA); PG8_STAGE(PG8_SB(0, 1), cB + hstep, voffB); PG8_STAGE(PG8_SA(0, 1), cA + hstep, voffA);
        if (wr == 1) PG8_BAR;
        PG8_WAIT_V(4); PG8_BAR;
        PG8_STAGE(PG8_SB(1, 0), cB + kstep, voffB); PG8_STAGE(PG8_SA(1, 0), cA + kstep, voffA); PG8_STAGE(PG8_SB(1, 1), cB + hstep + kstep, voffB);
        PG8_WAIT_V(6); PG8_BAR;
    }
    for (;;) {
        const bool has_next = S.next(ui + 1, nxt);
        const char* nA = has_next ? (const char*)g.A + (size_t)nxt.pm * tstep : cA; const char* nB = has_next ? (const char*)g.Bt + (size_t)nxt.pn * tstep : cB;
        for (int t = 0; t < nt; t += 2) {
            const bool last = (t == nt - 2);
            const char* a1 = cA + (size_t)(t + 1) * kstep;
            const char* a2 = last ? nA : cA + (size_t)(t + 2) * kstep; const char* b2 = last ? nB : cB + (size_t)(t + 2) * kstep;
            const char* a3 = a2 + kstep; const char* b3 = b2 + kstep;
            if (last && has_next) S.a_ready(nxt);
            if constexpr (SP2) {
            PG8_LDB(B0, 0, 0); PG8_LDB(B1, 0, 1); PG8_SCHED; PG8_LDA(At, 0, 0); PG8_STAGE(PG8_SA(1, 1), a1 + hstep, voffA);
            PG8_WAIT_V(8); PG8_WAIT_L(0); PG8_BAR; PG8_MMA(0, 0, At, B0); PG8_MMA(0, 1, At, B1); PG8_BAR; PG8_SCHED;
            PG8_LDA(At, 0, 1); PG8_STAGE(PG8_SB(0, 0), b2, voffB); PG8_STAGE(PG8_SB(0, 1), b2 + hstep, voffB); PG8_STAGE(PG8_SA(0, 0), a2, voffA);
            PG8_WAIT_V(8); PG8_WAIT_L(0); PG8_BAR; PG8_MMA(1, 0, At, B0); PG8_MMA(1, 1, At, B1); PG8_BAR; PG8_SCHED;
            PG8_LDB(B0, 1, 0); PG8_LDB(B1, 1, 1); PG8_SCHED; PG8_LDA(At, 1, 0); PG8_STAGE(PG8_SA(0, 1), a2 + hstep, voffA);
            PG8_WAIT_V(8); PG8_WAIT_L(0); PG8_BAR; PG8_MMA(0, 0, At, B0); PG8_MMA(0, 1, At, B1); PG8_BAR; PG8_SCHED;
            PG8_LDA(At, 1, 1); PG8_STAGE(PG8_SB(1, 0), b3, voffB); PG8_STAGE(PG8_SB(1, 1), b3 + hstep, voffB); PG8_STAGE(PG8_SA(1, 0), a3, voffA);
            PG8_WAIT_V(8); PG8_WAIT_L(0); PG8_BAR; PG8_MMA(1, 0, At, B0); PG8_MMA(1, 1, At, B1); PG8_BAR; PG8_SCHED;
            } else {
            PG8_LDB(B0, 0, 0); PG8_SCHED; PG8_LDA(At, 0, 0); PG8_STAGE(PG8_SA(1, 1), a1 + hstep, voffA);
            PG8_WAIT_L(8); PG8_BAR; PG8_WAIT_L(0); PG8_MMA(0, 0, At, B0); PG8_BAR; PG8_SCHED;
            PG8_LDB(B1, 0, 1); PG8_STAGE(PG8_SB(0, 0), b2, voffB);
            PG8_BAR; PG8_WAIT_L(0); PG8_MMA(0, 1, At, B1); PG8_BAR;
            PG8_LDA(At, 0, 1); PG8_STAGE(PG8_SA(0, 0), a2, voffA);
            PG8_BAR; PG8_WAIT_L(0); PG8_MMA(1, 0, At, B0); PG8_BAR; PG8_SCHED;
            PG8_STAGE(PG8_SB(0, 1), b2 + hstep, voffB);
            PG8_WAIT_V(6); PG8_BAR; PG8_MMA(1, 1, At, B1); PG8_BAR;
            PG8_LDB(B0, 1, 0); PG8_SCHED; PG8_LDA(At, 1, 0); PG8_STAGE(PG8_SA(0, 1), a2 + hstep, voffA);
            PG8_WAIT_L(8); PG8_BAR; PG8_WAIT_L(0); PG8_MMA(0, 0, At, B0); PG8_BAR; PG8_SCHED;
            PG8_LDB(B1, 1, 1); PG8_STAGE(PG8_SB(1, 0), b3, voffB);
            PG8_BAR; PG8_WAIT_L(0); PG8_MMA(0, 1, At, B1); PG8_BAR;
            PG8_LDA(At, 1, 1); PG8_STAGE(PG8_SA(1, 0), a3, voffA);
            PG8_BAR; PG8_WAIT_L(0); PG8_MMA(1, 0, At, B0); PG8_BAR; PG8_SCHED;
            PG8_STAGE(PG8_SB(1, 1), b3 + hstep, voffB);
            PG8_WAIT_V(6); PG8_BAR; PG8_MMA(1, 1, At, B1); PG8_BAR;
            }
        }
        if constexpr (ALIGN_EPI) { if (wr == 0) PG8_BAR; }
        if constexpr (!Epi::AFTER_DRAIN) { E(acc, cur, wr, wc, fr, fq); S.done(cur); }
        if (!has_next) break;
#pragma unroll
        for (int a = 0; a < 2; ++a)
#pragma unroll
            for (int b = 0; b < 2; ++b)
#pragma unroll
                for (int m = 0; m < 4; ++m)
#pragma unroll
                    for (int n = 0; n < 2; ++n) acc[a][b][m][n] = (f32x4){0.f, 0.f, 0.f, 0.f};
        cur = nxt; cA = nA; cB = nB; ++ui;
        if constexpr (ALIGN_EPI) { if (wr == 1) PG8_BAR; }
    }
    PG8_WAIT_V(0);
    if constexpr (!ALIGN_EPI) { if (wr == 0) PG8_BAR; }
    PG8_BAR;
    if constexpr (Epi::AFTER_DRAIN) { E.fused(acc, cur, wr, wc, fr, fq, lds, wid, lane); S.done(cur); }
#undef PG8_SA
#undef PG8_SB
#undef PG8_STAGE
#undef PG8_LDA
#undef PG8_LDB
#undef PG8_MMA
#undef PG8_WAIT_V
#undef PG8_WAIT_L
#undef PG8_BAR
#undef PG8_SCHED
}
}
#ifndef MK_N_LAUNCHES
#define MK_N_LAUNCHES 1
#endif
constexpr int NWAVES = 8, NPHASE = 8;
constexpr int D = 2048, TP = 8192, TS = 128, MTOT = 8320, MP = 8448, SEQ = 2048, NB = 4, NIN = 3072, WL = 1024, FF = 8192;
constexpr float EPS = 1e-6f;
constexpr size_t MiB = 1u << 20;
constexpr size_t WS_CTL = 0, CTL_ZERO_BYTES = 1 * MiB;
constexpr size_t WS_WUP = 1 * MiB, WS_WDOWN = 33 * MiB, WS_WIN = 65 * MiB, WS_WOUT = 77 * MiB, WS_WA = 85 * MiB, WS_WX = WS_WA + 256 * 1024, WS_WPOOL = WS_WA + 512 * 1024;
constexpr size_t WS_H = 86 * MiB;
constexpr size_t WS_U = 119 * MiB;
constexpr size_t WS_X1B = 197 * MiB;
constexpr size_t WS_F = 65 * MiB;
constexpr size_t WS_AGGA = 231 * MiB, WS_AGGB = 232 * MiB;
constexpr size_t WS_END = 256 * MiB;
static_assert(WS_F + (size_t)MP * FF * 2 <= WS_X1B && WS_X1B + (size_t)MP * D * 2 <= WS_AGGA && WS_U + (size_t)MTOT * NIN * 4 <= WS_AGGA, "d_ws map");
constexpr int CW_BAR = 4096;
constexpr size_t WS_RSQ1 = 233 * MiB, WS_RSQ2 = 235 * MiB;
constexpr size_t WS_RSQD1 = 236 * MiB;
constexpr size_t WS_FD = 237 * MiB;
constexpr size_t WS_PD = 239 * MiB;
constexpr size_t O_Y = 0, O_HP = 17039360, O_CP = 17043456, O_PP = 17055744, O_HS = 17117184, O_CS = 17248256, O_PS = 17641472, O_END = 19607552;
constexpr size_t O_ACUM = 0, O_BCUM = 8388608;
constexpr int RING_BYTES = 131072, LDSCTL_OFF = RING_BYTES, LDS_BYTES = 147456;

#define LAS __attribute__((address_space(3)))
typedef unsigned short bf16;
typedef unsigned v4u __attribute__((ext_vector_type(4)));
typedef unsigned v2u __attribute__((ext_vector_type(2)));
typedef float f32x4 __attribute__((ext_vector_type(4)));
typedef float f32x2 __attribute__((ext_vector_type(2)));
typedef short bf16x8 __attribute__((ext_vector_type(8)));
#define LDS_WAIT() asm volatile("s_waitcnt lgkmcnt(0)" ::: "memory")
__device__ __forceinline__ unsigned pk2(float lo, float hi) { return pg8::cvt_pk_bf16(lo, hi); }
__device__ __forceinline__ bf16 f2bf(float f) { return (bf16)(pg8::cvt_pk_bf16(f, 0.f) & 0xffffu); }
__device__ __forceinline__ float sigmoidf_(float x) { return 1.0f / (1.0f + __expf(-x)); }
__device__ __forceinline__ float gelu_tanh(float x) { const float z = 0.7978845608028654f * (x + 0.044715f * x * x * x); const float t = 1.0f - 2.0f / (1.0f + __expf(2.0f * z)); return 0.5f * x * (1.0f + t); }

#define XB_TMO      128
#define XB_XCNT(j)  (256  + 64 * (j))
#define XB_XSUB(j)  (1280 + 64 * (j))
#define XB_XGEN(j)  (2304 + 64 * (j))
#define XB_TOP      3328
#define XB_TOPGEN   3392
#define XCD_BAR_WORDS 3456
#define XB_SPIN_CAP (1u << 18)

__device__ __forceinline__ unsigned xb_ld(unsigned* p)              { return __hip_atomic_load(p, __ATOMIC_RELAXED, __HIP_MEMORY_SCOPE_AGENT); }
__device__ __forceinline__ unsigned xb_add(unsigned* p, unsigned v) { return __hip_atomic_fetch_add(p, v, __ATOMIC_RELAXED, __HIP_MEMORY_SCOPE_AGENT); }
__device__ __forceinline__ unsigned xb_xcc_id() { return (unsigned)__builtin_amdgcn_s_getreg((3 << 11) | 20) & 0xFu; }
#define XB_SPIN(cond, bar) do { unsigned _sp = 0; while (cond) { __builtin_amdgcn_s_sleep(1); \
    if ((++_sp & 255u) == 0u) { if (xb_ld(&(bar)[XB_TMO])) break; if (_sp > XB_SPIN_CAP) { atomicAdd(&(bar)[XB_TMO], 1u); break; } } } } while (0)

struct XcdBarrier {
    unsigned* bar; unsigned x;
    volatile LAS unsigned* st;
};

__device__ __forceinline__ XcdBarrier xcd_barrier_post(unsigned* bar, volatile LAS unsigned* st) {
    XcdBarrier b; b.bar = bar; b.x = xb_xcc_id(); b.st = st;
    if (threadIdx.x == 0) (void)xb_add(&bar[XB_XCNT(b.x)], 1u);
    return b;
}
__device__ __forceinline__ void xcd_barrier_complete(unsigned* bar, unsigned x, unsigned& nloc, unsigned& nx) {
    const unsigned G = gridDim.x * gridDim.y * gridDim.z;
    unsigned sum, cnt, mine, sp = 0u;
    for (;;) {
        sum = 0u; cnt = 0u; mine = 0u;
#pragma unroll
        for (unsigned j = 0; j < 16; ++j) { const unsigned c = xb_ld(&bar[XB_XCNT(j)]); sum += c; cnt += (c > 0u) ? 1u : 0u; mine = (j == x) ? c : mine; }
        if (sum == G) break;
        __builtin_amdgcn_s_sleep(1);
        if ((++sp & 255u) == 0u) { if (xb_ld(&bar[XB_TMO])) break; if (sp > XB_SPIN_CAP) { atomicAdd(&bar[XB_TMO], 1u); break; } }
    }
    nloc = mine > 0u ? mine : 1u; nx = cnt > 0u ? cnt : 1u;
}

__device__ __forceinline__ void xcd_barrier(const XcdBarrier& b) {
    asm volatile("s_waitcnt vmcnt(0)" ::: "memory");
    __syncthreads();
    if (threadIdx.x == 0) {
        unsigned* bar = b.bar;
        __builtin_amdgcn_s_waitcnt(0);
        unsigned nloc = b.st[0], nx = b.st[1];
        if (nloc == 0u) { xcd_barrier_complete(bar, b.x, nloc, nx); b.st[0] = nloc; b.st[1] = nx; }
        const unsigned old = xb_add(&bar[XB_XSUB(b.x)], 1u);
        const unsigned gen = old / nloc;
        if (old + 1u == (gen + 1u) * nloc) {
            __builtin_amdgcn_fence(__ATOMIC_RELEASE, "agent");
            asm volatile("s_waitcnt vmcnt(0)" ::: "memory");
            const unsigned og = xb_add(&bar[XB_TOP], 1u);
            const unsigned tg = og / nx;
            if (og + 1u == (tg + 1u) * nx) xb_add(&bar[XB_TOPGEN], 1u);
            else XB_SPIN(xb_ld(&bar[XB_TOPGEN]) == tg, bar);
            __builtin_amdgcn_fence(__ATOMIC_ACQUIRE, "agent");
            xb_add(&bar[XB_XGEN(b.x)], 1u);
            asm volatile("s_waitcnt vmcnt(0)" ::: "memory");
        } else {
            XB_SPIN(xb_ld(&bar[XB_XGEN(b.x)]) == gen, bar);
            __builtin_amdgcn_fence(__ATOMIC_ACQUIRE, "agent");
            asm volatile("s_waitcnt vmcnt(0)" ::: "memory");
        }
    }
    __syncthreads();
}
template <class Epi>
__device__ __forceinline__ void dec_gemm_unit(LAS unsigned char* lds, const bf16* A, int lda, const bf16* W, int ldw, int n0, const Epi& E) {
    const int tid = threadIdx.x, lane = tid & 63, wave = __builtin_amdgcn_readfirstlane(tid >> 6), fr = lane & 15, fq = lane >> 4, sg = wave >> 2, kq = wave & 3;
    const bf16* ap = A + (size_t)(sg * 64 + fr) * lda + kq * 512 + fq * 8;
    const bf16* wp = W + (size_t)(n0 + fr) * ldw + kq * 512 + fq * 8;
    f32x4 acc[4][2];
#pragma unroll
    for (int s = 0; s < 4; ++s) { acc[s][0] = (f32x4){0.f, 0.f, 0.f, 0.f}; acc[s][1] = (f32x4){0.f, 0.f, 0.f, 0.f}; }
    bf16x8 ar[4][4], br[4][2];
#define DG_LOAD(slot, j) do { _Pragma("unroll") for (int s = 0; s < 4; ++s) ar[slot][s] = *(const bf16x8*)(ap + (size_t)(s * 16) * lda + (j) * 32); \
        br[slot][0] = *(const bf16x8*)(wp + (j) * 32); br[slot][1] = *(const bf16x8*)(wp + (size_t)16 * ldw + (j) * 32); } while (0)
#pragma unroll
    for (int j = 0; j < 4; ++j) DG_LOAD(j, j);
#pragma unroll
    for (int j = 0; j < 16; ++j) { const int slot = j & 3;
#pragma unroll
        for (int s = 0; s < 4; ++s) { acc[s][0] = __builtin_amdgcn_mfma_f32_16x16x32_bf16(br[slot][0], ar[slot][s], acc[s][0], 0, 0, 0); acc[s][1] = __builtin_amdgcn_mfma_f32_16x16x32_bf16(br[slot][1], ar[slot][s], acc[s][1], 0, 0, 0); }
        if (j + 4 < 16) DG_LOAD(slot, j + 4); }
#undef DG_LOAD
    LAS f32x4* slab = (LAS f32x4*)lds;
#pragma unroll
    for (int s = 0; s < 4; ++s) { slab[(kq * 16 + (sg * 4 + s) * 2 + 0) * 64 + lane] = acc[s][0]; slab[(kq * 16 + (sg * 4 + s) * 2 + 1) * 64 + lane] = acc[s][1]; }
    __syncthreads();
    f32x4 v[2];
#pragma unroll
    for (int ct = 0; ct < 2; ++ct) { v[ct] = slab[(0 * 16 + wave * 2 + ct) * 64 + lane];
#pragma unroll
        for (int q = 1; q < 4; ++q) v[ct] += slab[(q * 16 + wave * 2 + ct) * 64 + lane]; }
    E(wave * 16 + fr, n0 + fq * 4, fq, v);
    __syncthreads();
}
struct DEpiOut { const float* xs; float* X1; bf16* X1b; float* rsq;
    __device__ __forceinline__ void operator()(int row, int col, int fq, const f32x4 (&v)[2]) const { float ss = 0.f;
#pragma unroll
        for (int ct = 0; ct < 2; ++ct) { const size_t o = (size_t)row * D + col + ct * 16; const f32x4 x = v[ct] + *(const f32x4*)(xs + o); *(f32x4*)(X1 + o) = x; ss += pg8::dot4(x);
            v2u w; w.x = pk2(x[0], x[1]); w.y = pk2(x[2], x[3]); *(v2u*)(X1b + o) = w; }
        ss += __shfl_xor(ss, 16); ss += __shfl_xor(ss, 32);
        if (fq == 0) rsq[row * 64 + (col >> 5)] = ss; }
};
struct DEpiUp { bf16* Fd; const float* rsq;
    __device__ __forceinline__ void operator()(int row, int col, int fq, const f32x4 (&v)[2]) const {
        const float* rp = rsq + row * 64 + fq * 16; float t = 0.f;
#pragma unroll
        for (int i = 0; i < 4; ++i) { const f32x4 p = *(const f32x4*)(rp + 4 * i); t += (p[0] + p[1]) + (p[2] + p[3]); }
        t += __shfl_xor(t, 16); t += __shfl_xor(t, 32);
        const float s = 1.0f / sqrtf(t * (1.0f / D) + EPS);
#pragma unroll
        for (int ct = 0; ct < 2; ++ct) { f32x4 x = v[ct] * s;
#pragma unroll
            for (int j = 0; j < 4; ++j) { const float a = fmaxf(x[j], 0.f); x[j] = a * a; }
            v2u w; w.x = pk2(x[0], x[1]); w.y = pk2(x[2], x[3]); *(v2u*)(Fd + (size_t)row * FF + col + ct * 16) = w; } }
};
struct DEpiDown { float* Pd;
    __device__ __forceinline__ void operator()(int row, int col, int fq, const f32x4 (&v)[2]) const {
#pragma unroll
        for (int ct = 0; ct < 2; ++ct) *(f32x4*)(Pd + (size_t)row * D + col + ct * 16) = v[ct]; }
};

struct Args { const float* in[21]; float* out; unsigned char* ws; int ph_lo, ph_hi; };
enum { I_XP = 0, I_XS, I_SLRU, I_SCONV, I_SPOOL, I_GMIX, I_WIN, I_CONVW, I_CONVB, I_WA, I_BA, I_WX, I_BX, I_LAM, I_WPOOL, I_PSCALE, I_WOUT, I_GMLP, I_WUP, I_WDOWN, I_GFIN };

__device__ __forceinline__ float wave_sum(float v) {
#pragma unroll
    for (int o = 1; o < 64; o <<= 1) v += __shfl_xor(v, o);
    return v;
}
__device__ __forceinline__ void p0_transpose_item(const float* W, int K, int N, bf16* WT, const float* kscale, LAS float* scr, int item, int lane) {
    const int nblk = N / 32, kb = item / nblk, nb = item % nblk, k0 = 64 * kb, n0 = 32 * nb;
    float wv[32];
#pragma unroll
    for (int i = 0; i < 32; ++i) wv[i] = W[(size_t)(k0 + 2 * i + (lane >> 5)) * N + n0 + (lane & 31)];
    if (kscale) {
#pragma unroll
        for (int i = 0; i < 32; ++i) wv[i] *= kscale[k0 + 2 * i + (lane >> 5)]; }
#pragma unroll
    for (int i = 0; i < 32; ++i) scr[(2 * i + (lane >> 5)) * 33 + (lane & 31)] = wv[i];
    LDS_WAIT(); asm volatile("" ::: "memory");
    const int c = lane & 7;
#pragma unroll
    for (int j = 0; j < 4; ++j) { const int n = (lane >> 3) + 8 * j; const LAS float* s = scr + (8 * c) * 33 + n;
        v4u o; o.x = pk2(s[0 * 33], s[1 * 33]); o.y = pk2(s[2 * 33], s[3 * 33]); o.z = pk2(s[4 * 33], s[5 * 33]); o.w = pk2(s[6 * 33], s[7 * 33]);
        *(v4u*)(WT + (size_t)(n0 + n) * K + k0 + 8 * c) = o; }
    LDS_WAIT(); asm volatile("" ::: "memory");
}

__device__ __forceinline__ void phase0(const Args& a, LAS unsigned char* lds, int G) {
    const int tid = threadIdx.x, lane = tid & 63, wave = __builtin_amdgcn_readfirstlane(tid >> 6);
    unsigned char* ws = a.ws;
    LAS float* scr = (LAS float*)(lds + wave * 16384);
    const int gw = blockIdx.x * NWAVES + wave, NGW = G * NWAVES;
    constexpr int I_IN = (D / 64) * (NIN / 32), I_OUT = (D / 64) * (D / 32), I_UP = (D / 64) * (FF / 32), I_DOWN = (FF / 64) * (D / 32), I_G = 8 * 8, I_P = 4 * 32;
    constexpr int NITEMS = I_IN + I_OUT + I_UP + I_DOWN + 2 * I_G + I_P;
    for (int m = gw; m < MP; m += NGW) {
        bf16* orow = (bf16*)(ws + WS_H) + (size_t)m * D;
        if (m >= MTOT) {
#pragma unroll
            for (int j = 0; j < 4; ++j) *((v4u*)orow + lane + 64 * j) = (v4u){0u, 0u, 0u, 0u};
            continue;
        }
        const float* xrow = (m < TP) ? a.in[I_XP] + (size_t)m * D : a.in[I_XS] + (size_t)(m - TP) * D;
        const f32x4* xr = (const f32x4*)xrow + lane; const f32x4* gr = (const f32x4*)a.in[I_GMIX] + lane;
        f32x4 v[8]; float s = 0.f;
#pragma unroll
        for (int j = 0; j < 8; ++j) { v[j] = xr[64 * j]; s += pg8::dot4(v[j]); }
        const float rstd = 1.0f / sqrtf(wave_sum(s) * (1.0f / D) + EPS);
        v2u* o8 = (v2u*)orow + lane;
#pragma unroll
        for (int j = 0; j < 8; ++j) { const f32x4 g = gr[64 * j]; v2u o; o.x = pk2(v[j][0] * rstd * g[0], v[j][1] * rstd * g[1]); o.y = pk2(v[j][2] * rstd * g[2], v[j][3] * rstd * g[3]); o8[64 * j] = o; }
    }
    for (int it = gw; it < NITEMS; it += NGW) {
        int r = it;
        if (r < I_IN) { p0_transpose_item(a.in[I_WIN], D, NIN, (bf16*)(ws + WS_WIN), nullptr, scr, r, lane); continue; } r -= I_IN;
        if (r < I_OUT) { p0_transpose_item(a.in[I_WOUT], D, D, (bf16*)(ws + WS_WOUT), nullptr, scr, r, lane); continue; } r -= I_OUT;
        if (r < I_UP) { p0_transpose_item(a.in[I_WUP], D, FF, (bf16*)(ws + WS_WUP), a.in[I_GMLP], scr, r, lane); continue; } r -= I_UP;
        if (r < I_DOWN) { p0_transpose_item(a.in[I_WDOWN], FF, D, (bf16*)(ws + WS_WDOWN), nullptr, scr, r, lane); continue; } r -= I_DOWN;
        if (r < I_G) { const int h = r >> 3; p0_transpose_item(a.in[I_WA] + h * 16384, 128, 128, (bf16*)(ws + WS_WA) + h * 16384, nullptr, scr, r & 7, lane); continue; } r -= I_G;
        if (r < I_G) { const int h = r >> 3; p0_transpose_item(a.in[I_WX] + h * 16384, 128, 128, (bf16*)(ws + WS_WX) + h * 16384, nullptr, scr, r & 7, lane); continue; } r -= I_G;
        { const int g = r >> 5; p0_transpose_item(a.in[I_WPOOL] + g * 65536, 256, 256, (bf16*)(ws + WS_WPOOL) + g * 65536, nullptr, scr, r & 31, lane); }
    }
}

constexpr int XCS = 132, XAS = 136, PAS = 264;
__device__ __forceinline__ float softplusf_(float z) { return fmaxf(z, 0.f) + log1pf(__expf(-fabsf(z))); }

__device__ __forceinline__ void lru_unit(const Args& a, LAS unsigned char* lds, bool decode, int b, int ch, int h) {
    const int tid = threadIdx.x, lane = tid & 63, wave = __builtin_amdgcn_readfirstlane(tid >> 6), fr = lane & 15, fq = lane >> 4;
    LAS float* XC = (LAS float*)lds; LAS float* AA = (LAS float*)(lds + 33792); LAS bf16* XA = (LAS bf16*)(lds + 67584); LAS float* SG = (LAS float*)(lds + 84992);
    const float* U = (const float*)(a.ws + WS_U);
    const int c = tid & 127, tq = tid >> 7, cg = h * 128 + c, t0 = ch * 64;
    const size_t rowbase = decode ? (size_t)(TP + ch * 16) : (size_t)b * SEQ + t0;
    const int cl = wave * 16 + fr, cgg = h * 128 + cl;
    bf16x8 wa[4], wx[4];
    { const bf16* WaT = (const bf16*)(a.ws + WS_WA) + (size_t)h * 16384 + cl * 128 + fq * 8; const bf16* WxT = (const bf16*)(a.ws + WS_WX) + (size_t)h * 16384 + cl * 128 + fq * 8;
#pragma unroll
      for (int kk = 0; kk < 4; ++kk) { wa[kk] = *(const bf16x8*)(WaT + kk * 32); wx[kk] = *(const bf16x8*)(WxT + kk * 32); } }
    const float ba_ = a.in[I_BA][cgg], bx_ = a.in[I_BX][cgg], lam_ = a.in[I_LAM][cgg];
    {
        const float* cw = a.in[I_CONVW]; const float w0 = cw[cg], w1 = cw[WL + cg], w2 = cw[2 * WL + cg], w3 = cw[3 * WL + cg], cb = a.in[I_CONVB][cg];
        const int ts = tq * 16;
        if (!decode) {
            float xv[19]; const bool halo = (t0 + ts) > 0;
#pragma unroll
            for (int i = 0; i < 19; ++i) { const int t = ts - 3 + i; const size_t row = (i < 3 && !halo) ? rowbase : rowbase + t; xv[i] = U[row * NIN + cg]; }
            if (!halo) { xv[0] = 0.f; xv[1] = 0.f; xv[2] = 0.f; }
#pragma unroll
            for (int s = 0; s < 16; ++s) { const int t = ts + s; const float xc = cb + w0 * xv[s] + w1 * xv[s + 1] + w2 * xv[s + 2] + w3 * xv[s + 3]; XC[t * XCS + c] = xc; XA[t * XAS + c] = f2bf(xc); }
            if (ch == SEQ / 64 - 1 && tq == 3) { float* cp = a.out + O_CP + (size_t)b * 3 * WL + cg; cp[0] = xv[16]; cp[WL] = xv[17]; cp[2 * WL] = xv[18]; }
        } else {
            const float* sc = a.in[I_SCONV]; float* cs = a.out + O_CS; float sv[4][4];
#pragma unroll
            for (int s = 0; s < 4; ++s) { const int t = tq * 4 + s; const int bi = ch * 16 + t;
                sv[s][0] = sc[((size_t)bi * 3 + 0) * WL + cg]; sv[s][1] = sc[((size_t)bi * 3 + 1) * WL + cg]; sv[s][2] = sc[((size_t)bi * 3 + 2) * WL + cg]; sv[s][3] = U[(rowbase + t) * NIN + cg]; }
#pragma unroll
            for (int s = 0; s < 4; ++s) { const int t = tq * 4 + s; const int bi = ch * 16 + t;
                const float xc = cb + w0 * sv[s][0] + w1 * sv[s][1] + w2 * sv[s][2] + w3 * sv[s][3]; XC[t * XCS + c] = xc; XA[t * XAS + c] = f2bf(xc);
                cs[((size_t)bi * 3 + 0) * WL + cg] = sv[s][1]; cs[((size_t)bi * 3 + 1) * WL + cg] = sv[s][2]; cs[((size_t)bi * 3 + 2) * WL + cg] = sv[s][3]; }
        }
    }
    __syncthreads();
    {
        const float sp = softplusf_(-lam_); const int nrs = decode ? 1 : 4;
        for (int rs = 0; rs < nrs; ++rs) {
            f32x4 acca = (f32x4){0.f, 0.f, 0.f, 0.f}, accx = (f32x4){0.f, 0.f, 0.f, 0.f};
#pragma unroll
            for (int kk = 0; kk < 4; ++kk) { const bf16x8 af = *(const LAS bf16x8*)(XA + (rs * 16 + fr) * XAS + kk * 32 + fq * 8);
                acca = __builtin_amdgcn_mfma_f32_16x16x32_bf16(af, wa[kk], acca, 0, 0, 0); accx = __builtin_amdgcn_mfma_f32_16x16x32_bf16(af, wx[kk], accx, 0, 0, 0); }
#pragma unroll
            for (int reg = 0; reg < 4; ++reg) { const int t = rs * 16 + fq * 4 + reg;
                const float r = sigmoidf_(acca[reg] + ba_), ig = sigmoidf_(accx[reg] + bx_);
                const float la = -8.0f * r * sp, av = __expf(la);
                const float mult = (!decode && t0 + t == 0) ? 1.0f : sqrtf(-expm1f(2.0f * la));
                const float xc = XC[t * XCS + cl]; XC[t * XCS + cl] = xc * ig * mult; AA[t * XCS + cl] = av; }
        }
    }
    __syncthreads();
    if (!decode) {
        float hh = 0.f, pp = 1.f;
#pragma unroll
        for (int s = 0; s < 16; ++s) { const int t = tq * 16 + s; const float av = AA[t * XCS + c], bv = XC[t * XCS + c]; hh = av * hh + bv; pp *= av; XC[t * XCS + c] = hh; AA[t * XCS + c] = pp; }
        SG[(tq * 128 + c) * 2] = pp; SG[(tq * 128 + c) * 2 + 1] = hh;
        __syncthreads();
        float Ain = 1.f, Bin = 0.f;
        for (int s2 = 0; s2 < tq; ++s2) { const float P = SG[(s2 * 128 + c) * 2], H = SG[(s2 * 128 + c) * 2 + 1]; Bin = P * Bin + H; Ain *= P; }
        float* Acum = a.out + O_ACUM; float* Bcum = a.out + O_BCUM; float ac = 0.f, bc = 0.f;
#pragma unroll
        for (int s = 0; s < 16; ++s) { const int t = tq * 16 + s; const float p = AA[t * XCS + c], hl = XC[t * XCS + c]; ac = p * Ain; bc = p * Bin + hl;
            Acum[(rowbase + t) * WL + cg] = ac; Bcum[(rowbase + t) * WL + cg] = bc; }
        if (tq == 3) { ((float*)(a.ws + WS_AGGA))[((size_t)b * 32 + ch) * WL + cg] = ac; ((float*)(a.ws + WS_AGGB))[((size_t)b * 32 + ch) * WL + cg] = bc; }
    } else {
        const float* h0 = a.in[I_SLRU]; float* hs = a.out + O_HS; bf16* Y = (bf16*)(a.ws + WS_H);
#pragma unroll
        for (int s = 0; s < 4; ++s) { const int t = tq * 4 + s; const int bi = ch * 16 + t;
            const float hn = AA[t * XCS + c] * h0[(size_t)bi * WL + cg] + XC[t * XCS + c]; hs[(size_t)bi * WL + cg] = hn;
            const float gate = U[(rowbase + t) * NIN + WL + cg]; Y[(rowbase + t) * D + cg] = f2bf(hn * gelu_tanh(gate)); }
    }
    __syncthreads();
}

__device__ __forceinline__ void pool_unit(const Args& a, LAS unsigned char* lds, bool decode, int b, int ch, int g) {
    const int tid = threadIdx.x, lane = tid & 63, wave = __builtin_amdgcn_readfirstlane(tid >> 6), fr = lane & 15, fq = lane >> 4;
    LAS float* PU = (LAS float*)lds; LAS bf16* PA = (LAS bf16*)(lds + 80896);
    const float* U = (const float*)(a.ws + WS_U);
    const int c = tid & 255, half = tid >> 8, cgp = g * 256 + c, t0 = ch * 64, w = 2 << g;
    const size_t rowbase = decode ? (size_t)(TP + ch * 16) : (size_t)b * SEQ + t0;
    bf16x8 wf[2][8];
    { const bf16* WT = (const bf16*)(a.ws + WS_WPOOL) + (size_t)g * 65536 + (size_t)(wave * 32 + fr) * 256 + fq * 8;
#pragma unroll
      for (int ct = 0; ct < 2; ++ct)
#pragma unroll
          for (int kk = 0; kk < 8; ++kk) wf[ct][kk] = *(const bf16x8*)(WT + ct * 16 * 256 + kk * 32); }
    if (!decode) {
        { const bool halo = ch > 0;
#pragma unroll 1
          for (int bt = 0; bt < 4; ++bt) { float pv[10];
#pragma unroll
            for (int i = 0; i < 10; ++i) { const int j = half + 2 * (bt * 10 + i); const int jc = j < 79 ? j : 78; const size_t row = (jc < 15 && !halo) ? rowbase : rowbase + jc - 15; pv[i] = U[row * NIN + 2 * WL + cgp]; }
#pragma unroll
            for (int i = 0; i < 10; ++i) { const int j = half + 2 * (bt * 10 + i); if (j < 79) PU[j * 256 + c] = (j < 15 && !halo) ? 0.f : pv[i]; } } }
        __syncthreads();
        if (ch == SEQ / 64 - 1) { float* pp = a.out + O_PP + (size_t)b * 15 * WL + cgp; for (int k = half; k < 15; k += 2) pp[(size_t)k * WL] = PU[(64 + k) * 256 + c]; }
        const int ts = half * 32; float S = 0.f;
        for (int i = 0; i < w; ++i) S += PU[(ts + 15 - i) * 256 + c];
        const float invw = 1.0f / (float)w;
#pragma unroll 4
        for (int s = 0; s < 32; ++s) { const int t = ts + s; const int pos = t0 + t; const float cur = PU[(t + 15) * 256 + c];
            const float inv = (pos + 1 >= w) ? invw : 1.0f / (float)(pos + 1);
            PA[t * PAS + c] = f2bf(S * inv - cur);
            if (s < 31) S += PU[(t + 16) * 256 + c] - PU[(t + 16 - w) * 256 + c]; }
    } else {
        const float* sp = a.in[I_SPOOL]; float* ps = a.out + O_PS; const float invw = 1.0f / (float)w;
#pragma unroll 1
        for (int s4 = 0; s4 < 4; ++s4) { float pv[2][16];
#pragma unroll
            for (int s = 0; s < 2; ++s) { const int t = half * 8 + s4 * 2 + s; const int bi = ch * 16 + t;
#pragma unroll
                for (int k = 0; k < 15; ++k) pv[s][k] = sp[((size_t)bi * 15 + k) * WL + cgp];
                pv[s][15] = U[(rowbase + t) * NIN + 2 * WL + cgp]; }
#pragma unroll
            for (int s = 0; s < 2; ++s) { const int t = half * 8 + s4 * 2 + s; const int bi = ch * 16 + t; float S = pv[s][15];
#pragma unroll
                for (int k = 0; k < 15; ++k) { if (k >= 16 - w) S += pv[s][k]; ps[((size_t)bi * 15 + k) * WL + cgp] = pv[s][k + 1]; }
                PA[t * PAS + c] = f2bf(S * invw - pv[s][15]); } }
    }
    __syncthreads();
    {
        bf16* Y = (bf16*)(a.ws + WS_H); const float* psc = a.in[I_PSCALE];
        const f32x4 sc0 = *(const f32x4*)(psc + g * 256 + wave * 32 + fq * 4), sc1 = *(const f32x4*)(psc + g * 256 + wave * 32 + 16 + fq * 4);
        const int nrs = decode ? 1 : 4;
        for (int rs = 0; rs < nrs; ++rs) { f32x4 acc0 = (f32x4){0.f, 0.f, 0.f, 0.f}, acc1 = (f32x4){0.f, 0.f, 0.f, 0.f};
#pragma unroll
            for (int kk = 0; kk < 8; ++kk) { const bf16x8 af = *(const LAS bf16x8*)(PA + (rs * 16 + fr) * PAS + kk * 32 + fq * 8);
                acc0 = __builtin_amdgcn_mfma_f32_16x16x32_bf16(wf[0][kk], af, acc0, 0, 0, 0); acc1 = __builtin_amdgcn_mfma_f32_16x16x32_bf16(wf[1][kk], af, acc1, 0, 0, 0); }
            bf16* yp = Y + (rowbase + rs * 16 + fr) * D + WL + g * 256 + wave * 32 + fq * 4;
            v2u o; o.x = pk2(acc0[0] * sc0[0], acc0[1] * sc0[1]); o.y = pk2(acc0[2] * sc0[2], acc0[3] * sc0[3]); *(v2u*)yp = o;
            o.x = pk2(acc1[0] * sc1[0], acc1[1] * sc1[1]); o.y = pk2(acc1[2] * sc1[2], acc1[3] * sc1[3]); *(v2u*)(yp + 16) = o; }
    }
    __syncthreads();
}

__device__ __forceinline__ void phase2(const Args& a, LAS unsigned char* lds, int G) {
    constexpr int N_LD = 8 * 8, N_PD = 8 * 4, N_PP = NB * 32 * 4, N_LP = NB * 32 * 8, NU = N_LD + N_PD + N_PP + N_LP;
    for (int it = blockIdx.x; it < NU; it += G) {
        int r = it;
        if (r < N_LD) { lru_unit(a, lds, true, 0, r >> 3, r & 7); continue; } r -= N_LD;
        if (r < N_PD) { pool_unit(a, lds, true, 0, r >> 2, r & 3); continue; } r -= N_PD;
        if (r < N_PP) { const int g = r & 3, ch = (r >> 2) & 31, b = r >> 7; pool_unit(a, lds, false, b, ch, g); continue; } r -= N_PP;
        { const int h = r & 7, ch = (r >> 3) & 31, b = r >> 8; lru_unit(a, lds, false, b, ch, h); }
    }
}

__device__ __forceinline__ void phase2b(const Args& a, LAS unsigned char* lds, int G) {
    const int tid = threadIdx.x; const float* U = (const float*)(a.ws + WS_U); bf16* Y = (bf16*)(a.ws + WS_H);
    const float* Acum = a.out + O_ACUM; const float* Bcum = a.out + O_BCUM; const float* AggA = (const float*)(a.ws + WS_AGGA); const float* AggB = (const float*)(a.ws + WS_AGGB);
    for (int j = blockIdx.x; j < D / 32; j += G) {
        DEpiOut E{a.in[I_XS], a.out + O_Y + (size_t)TP * D, (bf16*)(a.ws + WS_X1B) + (size_t)TP * D, (float*)(a.ws + WS_RSQD1)};
        dec_gemm_unit(lds, (const bf16*)(a.ws + WS_H) + (size_t)TP * D, D, (const bf16*)(a.ws + WS_WOUT), D, 32 * j, E); }
    for (int it = blockIdx.x; it < NB * 32 * 2; it += G) {
        const int rh = it & 1, ch = (it >> 1) & 31, b = it >> 6, c2 = tid * 2;
        f32x2 carry = (f32x2){0.f, 0.f};
#pragma unroll
        for (int k = 0; k < 31; ++k) { const f32x2 A = *(const f32x2*)(AggA + ((size_t)b * 32 + k) * WL + c2), B = *(const f32x2*)(AggB + ((size_t)b * 32 + k) * WL + c2); const f32x2 nc = A * carry + B; carry = (k < ch) ? nc : carry; }
        const size_t row0 = (size_t)b * SEQ + ch * 64 + rh * 32; f32x2 hlast = (f32x2){0.f, 0.f};
#pragma unroll 4
        for (int r = 0; r < 32; ++r) { const size_t row = row0 + r;
            const f32x2 A = *(const f32x2*)(Acum + row * WL + c2), B = *(const f32x2*)(Bcum + row * WL + c2), gt = *(const f32x2*)(U + row * NIN + WL + c2);
            const f32x2 hv = A * carry + B; hlast = hv;
            *(unsigned*)(Y + row * D + c2) = pk2(hv.x * gelu_tanh(gt.x), hv.y * gelu_tanh(gt.y)); }
        if (ch == 31 && rh == 1) *(f32x2*)(a.out + O_HP + (size_t)b * WL + c2) = hlast;
    }
}

__device__ __forceinline__ void phase6(const Args& a, int G) {
    const int tid = threadIdx.x, lane = tid & 63, wave = tid >> 6; const float* rsq = (const float*)(a.ws + WS_RSQ2);
    const f32x4* gr = (const f32x4*)a.in[I_GFIN] + lane;
    for (int m = blockIdx.x * NWAVES + wave; m < MTOT; m += G * NWAVES) {
        f32x4* xr = (f32x4*)(a.out + O_Y + (size_t)m * D) + lane;
        if (m < TP) {
            const float rstd = 1.0f / sqrtf(wave_sum(lane < 32 ? rsq[(size_t)m * 32 + lane] : 0.f) * (1.0f / D) + EPS);
#pragma unroll
            for (int j = 0; j < 8; ++j) { const f32x4 g = gr[64 * j]; xr[64 * j] = xr[64 * j] * rstd * g; }
        } else {
            const f32x4* pd = (const f32x4*)(a.ws + WS_PD) + (size_t)(m - TP) * (D / 4) + lane; f32x4 v[8]; float s = 0.f;
#pragma unroll
            for (int j = 0; j < 8; ++j) { v[j] = xr[64 * j];
#pragma unroll
                for (int q = 0; q < 4; ++q) v[j] += pd[(size_t)q * TS * (D / 4) + 64 * j];
                s += pg8::dot4(v[j]); }
            const float rstd = 1.0f / sqrtf(wave_sum(s) * (1.0f / D) + EPS);
#pragma unroll
            for (int j = 0; j < 8; ++j) { const f32x4 g = gr[64 * j]; xr[64 * j] = v[j] * rstd * g; }
        }
    }
}

#ifndef PHASE_SEQ
#define PHASE_SEQ {0, 1, 2, 3, 4, 5, 6, 7}
#endif
constexpr int kSeq[] = PHASE_SEQ; constexpr int kNSeq = sizeof(kSeq) / sizeof(int);
template <int K> __device__ __forceinline__ void run_phase(const Args& args, LAS unsigned char* lds, int G) {
    unsigned char* ws = args.ws; float* rsq1 = (float*)(ws + WS_RSQ1); float* rsq2 = (float*)(ws + WS_RSQ2);
    if constexpr (K == 0) { phase0(args, lds, G); }
    if constexpr (K == 1) {
        pg8::Gemm g{(const pg8::bf16_t*)(ws + WS_H), (const pg8::bf16_t*)(ws + WS_WIN), MP, NIN, D}; pg8::StaticOrder S; S.init(MP, NIN, G, (int)blockIdx.x);
        pg8::EpiU E{(float*)(ws + WS_U), NIN};
        pg8::gemm_phase<pg8::EpiU, pg8::StaticOrder, true, true>(lds, g, S, E);
    }
    if constexpr (K == 2) { phase2(args, lds, G); }
    if constexpr (K == 3) { phase2b(args, lds, G); }
    if constexpr (K == 4) {
        for (int j = blockIdx.x; j < FF / 32; j += G) {
            DEpiUp E{(bf16*)(ws + WS_FD), (const float*)(ws + WS_RSQD1)};
            dec_gemm_unit(lds, (const bf16*)(ws + WS_X1B) + (size_t)TP * D, D, (const bf16*)(ws + WS_WUP), D, 32 * j, E); }
        pg8::Gemm g{(const pg8::bf16_t*)(ws + WS_H), (const pg8::bf16_t*)(ws + WS_WOUT), TP, D, D}; pg8::StaticOrder S; S.init(TP, D, G, (int)blockIdx.x);
        pg8::EpiOut E{args.in[I_XP], args.out + O_Y, (pg8::bf16_t*)(ws + WS_X1B), rsq1};
        pg8::gemm_phase<pg8::EpiOut, pg8::StaticOrder, true, true>(lds, g, S, E);
    }
    if constexpr (K == 5) {
        for (int j = blockIdx.x; j < 4 * (D / 32); j += G) {
            const int ks = j >> 6, nt = j & 63; DEpiDown E{(float*)(ws + WS_PD) + (size_t)ks * TS * D};
            dec_gemm_unit(lds, (const bf16*)(ws + WS_FD) + ks * 2048, FF, (const bf16*)(ws + WS_WDOWN) + ks * 2048, FF, 32 * nt, E); }
        pg8::Gemm g{(const pg8::bf16_t*)(ws + WS_X1B), (const pg8::bf16_t*)(ws + WS_WUP), TP, FF, D}; pg8::StaticOrder S; S.init(TP, FF, G, (int)blockIdx.x);
        pg8::EpiUp E{(pg8::bf16_t*)(ws + WS_F), rsq1};
        pg8::gemm_phase<pg8::EpiUp, pg8::StaticOrder, true, true>(lds, g, S, E);
    }
    if constexpr (K == 6) {
        pg8::Gemm g{(const pg8::bf16_t*)(ws + WS_F), (const pg8::bf16_t*)(ws + WS_WDOWN), TP, D, FF}; pg8::StaticOrder S; S.init(TP, D, G, (int)blockIdx.x);
        pg8::EpiDown E{args.out + O_Y, rsq2};
        pg8::gemm_phase<pg8::EpiDown, pg8::StaticOrder, true, true>(lds, g, S, E);
    }
    if constexpr (K == 7) { phase6(args, G); }
    if constexpr (K == 8) {
        pg8::Gemm g{(const pg8::bf16_t*)(ws + WS_F), (const pg8::bf16_t*)(ws + WS_WDOWN), TP, D, FF}; pg8::StaticOrder S; S.init(TP, D, G, (int)blockIdx.x);
        pg8::EpiBf16Plain E{(pg8::bf16_t*)(ws + WS_X1B)};
        pg8::gemm_phase<pg8::EpiBf16Plain, pg8::StaticOrder, true, true>(lds, g, S, E);
    }
}
__global__ void __launch_bounds__(NWAVES * 64, 2) hymba_fwd(Args args) {
    extern __shared__ __attribute__((aligned(16))) unsigned char lds_raw[];
    LAS unsigned char* lds = (LAS unsigned char*)lds_raw;
    const int tid = threadIdx.x, G = gridDim.x;
    unsigned char* ws = args.ws;
    unsigned* ctl = (unsigned*)(ws + WS_CTL);
    for (int u = tid; u < (LDS_BYTES - LDSCTL_OFF) / 4; u += NWAVES * 64) ((LAS unsigned*)(lds + LDSCTL_OFF))[u] = 0u;
    __syncthreads();
    XcdBarrier bar; bar.bar = ctl + CW_BAR; bar.x = 0; bar.st = nullptr;
    if (MK_N_LAUNCHES == 1) bar = xcd_barrier_post(ctl + CW_BAR, (volatile LAS unsigned*)(lds + LDSCTL_OFF + 64));
    const int lo = args.ph_lo, hi = args.ph_hi;
#define RUN(si) do { if constexpr ((si) < kNSeq) { if (lo <= (si) && (si) < hi) { run_phase<kSeq[(si) < kNSeq ? (si) : 0]>(args, lds, G); if ((si) + 1 < hi) xcd_barrier(bar); } } } while (0)
    RUN(0); RUN(1); RUN(2); RUN(3); RUN(4); RUN(5); RUN(6); RUN(7); RUN(8); RUN(9); RUN(10); RUN(11);
#undef RUN
}

extern "C" void kernel_launch(void* const* d_in, const int* in_sizes, int n_in, void* d_out, int out_size, void* d_ws, size_t ws_size, hipStream_t stream) {
    static int grid = 0;
    if (grid == 0) {
        if (n_in != 21 || (size_t)out_size != O_END || ws_size < WS_END) { fprintf(stderr, "kernel_launch: unexpected shapes: n_in %d out %d ws %zu\n", n_in, out_size, ws_size); grid = -1; return; }
        int dev = 0, cus = 0, per_cu = 0;
        if (hipGetDevice(&dev) != hipSuccess || hipDeviceGetAttribute(&cus, hipDeviceAttributeMultiprocessorCount, dev) != hipSuccess) { grid = -1; return; }
        if (hipFuncSetAttribute((const void*)hymba_fwd, hipFuncAttributeMaxDynamicSharedMemorySize, LDS_BYTES) != hipSuccess) { fprintf(stderr, "kernel_launch: hipFuncSetAttribute failed\n"); grid = -1; return; }
        if (hipOccupancyMaxActiveBlocksPerMultiprocessor(&per_cu, (const void*)hymba_fwd, NWAVES * 64, LDS_BYTES) != hipSuccess || per_cu < 1) { fprintf(stderr, "kernel_launch: occupancy query says %d\n", per_cu); per_cu = 1; }
        (void)hipGetLastError();
        grid = cus;
    }
    if (grid < 0) return;
    (void)hipMemsetAsync((char*)d_ws + WS_CTL, 0, CTL_ZERO_BYTES, stream);
    Args a{};
    for (int i = 0; i < 21; ++i) a.in[i] = (const float*)d_in[i];
    a.out = (float*)d_out; a.ws = (unsigned char*)d_ws;
#if MK_N_LAUNCHES == 1
    a.ph_lo = 0; a.ph_hi = kNSeq;
    void* kargs[] = {&a};
    hipError_t e = hipLaunchCooperativeKernel((const void*)hymba_fwd, dim3(grid), dim3(NWAVES * 64), kargs, LDS_BYTES, stream);
    if (e != hipSuccess) fprintf(stderr, "kernel_launch: cooperative launch failed: %s (grid %d)\n", hipGetErrorString(e), grid);
#else
    for (int p = 0; p < kNSeq; ++p) { a.ph_lo = p; a.ph_hi = p + 1; hipLaunchKernelGGL(hymba_fwd, dim3(grid), dim3(NWAVES * 64), LDS_BYTES, stream, a); }
#endif
}
```
